# Optimizing an MI355X kernel written in HIP

```python
import math
import jax, jax.numpy as jnp
from jax import lax
import numpy as np


D_MODEL = 1024
BATCH = 2
SEQ = 16384
DEPTH = 2

HEAD_DIM = 64
BLK = 128
NSA_HEADS = 4
NSA_CMP_LEN = 32
NSA_CMP_STRIDE = 16
NSA_CMP_HIDDEN = 256
NSA_SEL_BLK = 64
NSA_N_SEL = 16
NSA_N_LOCAL = 2
NSA_WINDOW = 512
SWA_HEADS = 8
SWA_KV_HEADS = 2
SWA_WINDOW = 128
SB_HEADS = 4
N_BUCKETS = 32
T5_MAX_DISTANCE = 4096
N_BIAS_HEADS = NSA_HEADS + SWA_HEADS
MIX_WIDTH = (NSA_HEADS + SWA_HEADS + SB_HEADS) * HEAD_DIM
D_FF = ((8 * D_MODEL // 3 + 255) // 256) * 256
IN_SPLITS = (NSA_HEADS * HEAD_DIM,
             HEAD_DIM, HEAD_DIM,
             HEAD_DIM, HEAD_DIM,
             HEAD_DIM, HEAD_DIM,
             3 * NSA_HEADS,
             SWA_HEADS * HEAD_DIM, SWA_KV_HEADS * HEAD_DIM, SWA_KV_HEADS * HEAD_DIM,
             SB_HEADS * HEAD_DIM, SB_HEADS * HEAD_DIM, SB_HEADS * HEAD_DIM)
IN_WIDTH = sum(IN_SPLITS)
RMS_EPS = 1e-6
FORCE_SCORE = 1e6

kernel_name = 'hybrid_nsa_swa_stickbreaking_block'


def rms_norm(x, g):
    xf = x.astype(jnp.float32)
    y = xf * lax.rsqrt(jnp.mean(xf * xf, axis=-1, keepdims=True) + RMS_EPS)
    return (y * g.astype(jnp.float32)).astype(x.dtype)


def split_heads(t, n):
    b, s, _ = t.shape
    return t.reshape(b, s, n, HEAD_DIM).transpose(0, 2, 1, 3)


def merge_heads(o):
    b, h, s, d = o.shape
    return o.transpose(0, 2, 1, 3).reshape(b, s, h * d)


def t5_bucket(dist):
    n = jnp.maximum(dist, 0)
    exact = N_BUCKETS // 2
    nf = jnp.maximum(n, 1).astype(jnp.float32)
    large = exact + (jnp.log(nf / exact) / math.log(T5_MAX_DISTANCE / exact)
                     * (N_BUCKETS - exact)).astype(jnp.int32)
    large = jnp.minimum(large, N_BUCKETS - 1)
    return jnp.where(n < exact, n, large)


def masked_softmax(logits, mask):
    m = jnp.max(jnp.where(mask, logits, -jnp.inf), axis=-1, keepdims=True)
    m = jnp.where(jnp.isfinite(m), m, 0.0)
    p = jnp.where(mask, jnp.exp(logits - m), 0.0)
    return p / jnp.maximum(jnp.sum(p, axis=-1, keepdims=True), 1e-30)


def band_blocks(k, n_prev):
    s, d = k.shape[-2], k.shape[-1]
    nb = s // BLK
    pad = [(0, 0)] * (k.ndim - 2) + [(n_prev * BLK, 0), (0, 0)]
    kp = jnp.pad(k, pad)
    parts = [kp[..., j * BLK: j * BLK + s, :].reshape(k.shape[:-2] + (nb, BLK, d))
             for j in range(n_prev + 1)]
    return jnp.concatenate(parts, axis=-2)


def banded_attention(q, k, v, window, bias_tab, sinks=None):
    b, g, r, s, d = q.shape
    nb = s // BLK
    n_prev = window // BLK
    kb = band_blocks(k, n_prev)
    vb = band_blocks(v, n_prev)
    nk = kb.shape[3]
    qb = q.reshape(b, g, r, nb, BLK, d)
    logits = jnp.einsum('bgrnqd,bgnkd->bgrnqk', qb, kb).astype(jnp.float32) / math.sqrt(d)
    qpos = jnp.arange(nb)[:, None] * BLK + jnp.arange(BLK)[None]
    kpos = jnp.arange(nb)[:, None] * BLK - n_prev * BLK + jnp.arange(nk)[None]
    dist = qpos[:, :, None] - kpos[:, None, :]
    mask = (dist >= 0) & (dist < window) & (kpos[:, None, :] >= 0)
    bias = bias_tab[t5_bucket(dist)].astype(jnp.float32).transpose(3, 0, 1, 2).reshape(g, r, nb, BLK, nk)
    logits = logits + bias
    m = jnp.max(jnp.where(mask, logits, -jnp.inf), axis=-1, keepdims=True)
    if sinks is not None:
        sk = sinks.astype(jnp.float32).reshape(1, g, r, 1, 1, 1)
        m = jnp.maximum(m, sk)
    p = jnp.where(mask, jnp.exp(logits - m), 0.0)
    denom = jnp.sum(p, axis=-1, keepdims=True)
    if sinks is not None:
        denom = denom + jnp.exp(sk - m)
    out = jnp.einsum('bgrnqk,bgnkd->bgrnqd', (p / denom).astype(v.dtype), vb)
    return out.reshape(b, g * r, s, d)


def nsa_compress(kv, pos, w1, b1, w2):
    b, s, d = kv.shape
    nc = (s - NSA_CMP_LEN) // NSA_CMP_STRIDE + 1
    idx = jnp.arange(nc)[:, None] * NSA_CMP_STRIDE + jnp.arange(NSA_CMP_LEN)[None]
    blocks = (kv[:, idx] + pos).reshape(b, nc, NSA_CMP_LEN * d)
    return jax.nn.silu(blocks @ w1 + b1) @ w2


def cmp_to_sel_weights(nc, ns):
    c0 = np.arange(nc)[:, None] * NSA_CMP_STRIDE
    s0 = np.arange(ns)[None, :] * NSA_SEL_BLK
    ov = np.minimum(c0 + NSA_CMP_LEN, s0 + NSA_SEL_BLK) - np.maximum(c0, s0)
    return jnp.asarray(np.clip(ov, 0, None) / NSA_CMP_LEN, dtype=jnp.float32)


def nsa_cmp_and_select(q, kc, vc, k_slc, v_slc, bias_tab):
    b, h, s, d = q.shape
    nb = s // BLK
    nc = kc.shape[1]
    ns = s // NSA_SEL_BLK
    n_sel = min(NSA_N_SEL, ns)
    scale = 1.0 / math.sqrt(d)
    wmap = cmp_to_sel_weights(nc, ns)
    cmp_end = jnp.arange(nc) * NSA_CMP_STRIDE + NSA_CMP_LEN - 1
    k_blocks = k_slc.reshape(b, ns, NSA_SEL_BLK, d)
    v_blocks = v_slc.reshape(b, ns, NSA_SEL_BLK, d)
    jsel = jnp.arange(ns)

    def block(n):
        qb = lax.dynamic_slice_in_dim(q, n * BLK, BLK, axis=2)
        t = n * BLK + jnp.arange(BLK)
        dist_c = t[:, None] - cmp_end[None]
        lc = jnp.einsum('bhqd,bcd->bhqc', qb, kc).astype(jnp.float32) * scale
        lc = lc + bias_tab[t5_bucket(dist_c)].astype(jnp.float32).transpose(2, 0, 1)
        pc = masked_softmax(lc, dist_c >= 0)
        o_c = jnp.einsum('bhqc,bcd->bhqd', pc.astype(vc.dtype), vc)
        imp = jnp.einsum('bhqc,cj->bqj', pc, wmap)
        cur = t // NSA_SEL_BLK
        valid_s = jsel[None] <= cur[:, None]
        forced = valid_s & ((jsel[None] == 0) | (jsel[None] > cur[:, None] - NSA_N_LOCAL))
        score = jnp.where(forced, FORCE_SCORE, jnp.where(valid_s, imp, -jnp.inf))
        _, idx = lax.top_k(score, n_sel)
        ks = jax.vmap(lambda kb_, i_: kb_[i_])(k_blocks, idx).reshape(b, BLK, n_sel * NSA_SEL_BLK, d)
        vs = jax.vmap(lambda vb_, i_: vb_[i_])(v_blocks, idx).reshape(b, BLK, n_sel * NSA_SEL_BLK, d)
        pos = (idx[..., None] * NSA_SEL_BLK + jnp.arange(NSA_SEL_BLK)).reshape(b, BLK, -1)
        dist_s = t[None, :, None] - pos
        ls = jnp.einsum('bhqd,bqkd->bhqk', qb, ks).astype(jnp.float32) * scale
        ls = ls + bias_tab[t5_bucket(dist_s)].astype(jnp.float32).transpose(0, 3, 1, 2)
        ps = masked_softmax(ls, (dist_s >= 0)[:, None])
        o_s = jnp.einsum('bhqk,bqkd->bhqd', ps.astype(vs.dtype), vs)
        return o_c, o_s

    o_c, o_s = lax.map(block, jnp.arange(nb))
    unblock = lambda o: o.transpose(1, 2, 0, 3, 4).reshape(b, h, s, d)
    return unblock(o_c), unblock(o_s)


def nsa_mixer(q, k_cmp, v_cmp, k_slc, v_slc, k_win, v_win, gate_logits, cmp_pos, w1, b1, w2, bias_tab):
    b, h, s, d = q.shape
    kc = nsa_compress(k_cmp, cmp_pos[0], w1[0], b1[0], w2[0])
    vc = nsa_compress(v_cmp, cmp_pos[1], w1[1], b1[1], w2[1])
    o_cmp, o_slc = nsa_cmp_and_select(q, kc, vc, k_slc, v_slc, bias_tab)
    o_win = banded_attention(q[:, None], k_win[:, None], v_win[:, None], NSA_WINDOW, bias_tab)
    g = jax.nn.sigmoid(gate_logits.astype(jnp.float32)).reshape(b, s, 3, h).transpose(2, 0, 3, 1)[..., None]
    g = g.astype(q.dtype)
    return g[0] * o_cmp + g[1] * o_slc + g[2] * o_win


def stick_breaking(q, k, v):
    b, h, s, d = q.shape
    nb = s // BLK
    spos = jnp.arange(s)

    def block(n):
        qb = lax.dynamic_slice_in_dim(q, n * BLK, BLK, axis=2)
        z = jnp.einsum('bhqd,bhkd->bhqk', qb, k).astype(jnp.float32) / math.sqrt(d)
        t = n * BLK + jnp.arange(BLK)
        before = spos[None] < t[:, None]
        log_not = jnp.where(before, jax.nn.log_sigmoid(-z), 0.0)
        later = lax.cumsum(log_not, axis=3, reverse=True) - log_not
        a = jnp.where(before, jnp.exp(jax.nn.log_sigmoid(z) + later), 0.0)
        return jnp.einsum('bhqk,bhkd->bhqd', a.astype(v.dtype), v)

    o = lax.map(block, jnp.arange(nb))
    return o.transpose(1, 2, 0, 3, 4).reshape(b, h, s, d)


def hybrid_mixer(h, w_in, cmp_pos, phi_w1, phi_b1, phi_w2, sinks, grp_g, rel_bias):
    b, s, _ = h.shape
    proj = h @ w_in
    split_points = [int(c) for c in np.cumsum(IN_SPLITS)[:-1]]
    (nq, kc, vc, ks, vs, kw, vw, ng, sq, sk, sv, bq, bk, bv) = jnp.split(proj, split_points, axis=-1)
    o_nsa = nsa_mixer(split_heads(nq, NSA_HEADS), kc, vc, ks, vs, kw, vw, ng,
                      cmp_pos, phi_w1, phi_b1, phi_w2, rel_bias[:, :NSA_HEADS])
    r = SWA_HEADS // SWA_KV_HEADS
    q_swa = split_heads(sq, SWA_HEADS).reshape(b, SWA_KV_HEADS, r, s, HEAD_DIM)
    o_swa = banded_attention(q_swa, split_heads(sk, SWA_KV_HEADS), split_heads(sv, SWA_KV_HEADS),
                             SWA_WINDOW, rel_bias[:, NSA_HEADS:], sinks)
    o_sb = stick_breaking(split_heads(bq, SB_HEADS), split_heads(bk, SB_HEADS), split_heads(bv, SB_HEADS))
    w_a = NSA_HEADS * HEAD_DIM
    w_b = w_a + SWA_HEADS * HEAD_DIM
    return jnp.concatenate([rms_norm(merge_heads(o_nsa), grp_g[:w_a]),
                            rms_norm(merge_heads(o_swa), grp_g[w_a:w_b]),
                            rms_norm(merge_heads(o_sb), grp_g[w_b:])], axis=-1)


def setup_inputs(seed: int = 0) -> dict:
    key = jax.random.key(seed)
    ks = jax.random.split(key, 18)
    nrm = lambda k, shape, sc: jax.random.normal(k, shape, jnp.float32) * sc
    gain = lambda k, shape: 1.0 + 0.05 * jax.random.normal(k, shape, jnp.float32)
    L = NSA_CMP_LEN
    return {
        'x': nrm(ks[0], (BATCH, SEQ, D_MODEL), 1.0),
        'rel_bias': nrm(ks[1], (N_BUCKETS, N_BIAS_HEADS), 0.2),
        'ln_attn_pre': gain(ks[2], (DEPTH, D_MODEL)),
        'w_in': nrm(ks[3], (DEPTH, D_MODEL, IN_WIDTH), D_MODEL ** -0.5),
        'nsa_cmp_pos': nrm(ks[4], (DEPTH, 2, L, HEAD_DIM), 0.2),
        'nsa_phi_w1': nrm(ks[5], (DEPTH, 2, L * HEAD_DIM, NSA_CMP_HIDDEN), (L * HEAD_DIM) ** -0.5),
        'nsa_phi_b1': nrm(ks[6], (DEPTH, 2, NSA_CMP_HIDDEN), 0.02),
        'nsa_phi_w2': nrm(ks[7], (DEPTH, 2, NSA_CMP_HIDDEN, HEAD_DIM), NSA_CMP_HIDDEN ** -0.5),
        'swa_sinks': nrm(ks[8], (DEPTH, SWA_HEADS), 0.5),
        'grp_norm_g': gain(ks[9], (DEPTH, MIX_WIDTH)),
        'w_out': nrm(ks[10], (DEPTH, MIX_WIDTH, D_MODEL), MIX_WIDTH ** -0.5),
        'ln_attn_post': gain(ks[11], (DEPTH, D_MODEL)),
        'ln_ffn_pre': gain(ks[12], (DEPTH, D_MODEL)),
        'ffn_w_gate': nrm(ks[13], (DEPTH, D_MODEL, D_FF), D_MODEL ** -0.5),
        'ffn_w_up': nrm(ks[14], (DEPTH, D_MODEL, D_FF), D_MODEL ** -0.5),
        'ffn_w_down': nrm(ks[15], (DEPTH, D_FF, D_MODEL), D_FF ** -0.5),
        'ln_ffn_post': gain(ks[16], (DEPTH, D_MODEL)),
    }


def reference(x, rel_bias, ln_attn_pre, w_in, nsa_cmp_pos, nsa_phi_w1, nsa_phi_b1, nsa_phi_w2,
              swa_sinks, grp_norm_g, w_out, ln_attn_post, ln_ffn_pre, ffn_w_gate, ffn_w_up,
              ffn_w_down, ln_ffn_post):
    for l in range(DEPTH):
        h = rms_norm(x, ln_attn_pre[l])
        mix = hybrid_mixer(h, w_in[l], nsa_cmp_pos[l], nsa_phi_w1[l], nsa_phi_b1[l], nsa_phi_w2[l],
                           swa_sinks[l], grp_norm_g[l], rel_bias)
        x = x + rms_norm(mix @ w_out[l], ln_attn_post[l])
        h = rms_norm(x, ln_ffn_pre[l])
        f = (jax.nn.silu(h @ ffn_w_gate[l]) * (h @ ffn_w_up[l])) @ ffn_w_down[l]
        x = x + rms_norm(f, ln_ffn_post[l])
    return x
```

```cpp
#include <hip/hip_runtime.h>
#include <cstdio>
#include <cstdint>
#ifndef PHMASK
#define PHMASK 0xFFF
#endif
namespace pg8 {
#define PG8_LAS __attribute__((address_space(3)))
typedef unsigned short bf16_t;
typedef short bf16x8 __attribute__((ext_vector_type(8)));
typedef float f32x4 __attribute__((ext_vector_type(4)));
typedef unsigned u32x4 __attribute__((ext_vector_type(4)));
constexpr int BM = 256, BK = 64, HALF = 128, HTB = HALF * BK * 2  , STAGE_BYTES = 8 * HTB, NXCD = 8, WGM = 8;

__host__ __device__ __forceinline__ int lds_byte(int r, int c) { const int st = (r >> 4) * 2 + (c >> 5), rr = r & 15, cc = c & 31, ob = rr * 64 + cc * 2; return st * 1024 + (ob ^ (((ob >> 9) & 1) << 5)); }
__host__ __device__ __forceinline__ void stage_rc(int b, int& R, int& C) { const int st = b / 1024, sb = b % 1024, swz = sb ^ (((sb >> 9) & 1) << 5); R = (st >> 1) * 16 + swz / 64; C = (st & 1) * 32 + (swz % 64) / 2; }
__host__ __device__ __forceinline__ int perm32(int rho) { const int n = rho >> 4, i = rho & 15; return 8 * (i >> 2) + 4 * n + (i & 3); }

struct Unit { int pm, pn; };
struct Gemm { const bf16_t* A; const bf16_t* Bt; int M, N, K; size_t a_row_bytes, a_kstep_bytes; };

struct StaticOrder {
    int nM, nN, nwg, G, c;
    __host__ __device__ void init(int M, int N, int G_, int c_) { nM = M / BM; nN = N / BM; nwg = nM * nN; G = G_; c = c_; }
    __host__ __device__ bool next(int i, Unit& u) const {
        const long L = (long)i * G + c; if (L >= nwg) return false;
        int wgid = (int)L; { const int q = nwg / NXCD, r = nwg % NXCD, xcd = wgid % NXCD, off = wgid / NXCD; wgid = (xcd < r ? xcd * (q + 1) : r * (q + 1) + (xcd - r) * q) + off; }
        const int nig = WGM * nN, gid = wgid / nig, fm = gid * WGM, gsz = (nM - fm) < WGM ? (nM - fm) : WGM;
        u.pm = fm + ((wgid % nig) % gsz); u.pn = (wgid % nig) / gsz; return true;
    }
    __device__ __forceinline__ void a_ready(const Unit&) const {}
    __device__ __forceinline__ void done(const Unit&) const {}
};

__device__ __forceinline__ unsigned cvt_pk_bf16(float lo, float hi) { unsigned r; asm volatile("v_cvt_pk_bf16_f32 %0, %1, %2" : "=v"(r) : "v"(lo), "v"(hi)); return r; }
typedef float f32x2 __attribute__((ext_vector_type(2)));
__device__ __forceinline__ float silu_f(float x) { return x * __builtin_amdgcn_rcpf(1.0f + __expf(-x)); }
template <int ACT  > struct EpiBf16 {
    static constexpr bool PERM = true, AFTER_DRAIN = false;
    bf16_t* O; int ldc; const float* bias;
    __device__ __forceinline__ void operator()(const f32x4 (&acc)[2][2][4][2], const Unit& u, int wr, int wc, int fr, int fq) const {
        const int row0 = u.pm * BM + wr * 64 + fr; const int col0 = u.pn * BM + wc * 32 + 8 * fq;
        f32x4 bv[2][2];
#pragma unroll
        for (int bj = 0; bj < 2; ++bj)
#pragma unroll
            for (int n = 0; n < 2; ++n) bv[bj][n] = bias ? *(const f32x4*)(bias + col0 + bj * HALF + 4 * n) : (f32x4){0.f, 0.f, 0.f, 0.f};
#pragma unroll
        for (int ai = 0; ai < 2; ++ai)
#pragma unroll
            for (int m = 0; m < 4; ++m) { bf16_t* rowp = O + (size_t)(row0 + ai * HALF + m * 16) * ldc + col0;
#pragma unroll
                for (int bj = 0; bj < 2; ++bj) { f32x4 v0 = acc[ai][bj][m][0] + bv[bj][0], v1 = acc[ai][bj][m][1] + bv[bj][1];
                    if (ACT == 2) { v0 = (f32x4){silu_f(v0[0]), silu_f(v0[1]), silu_f(v0[2]), silu_f(v0[3])}; v1 = (f32x4){silu_f(v1[0]), silu_f(v1[1]), silu_f(v1[2]), silu_f(v1[3])}; }
                    u32x4 w; w.x = cvt_pk_bf16(v0[0], v0[1]); w.y = cvt_pk_bf16(v0[2], v0[3]); w.z = cvt_pk_bf16(v1[0], v1[1]); w.w = cvt_pk_bf16(v1[2], v1[3]);
                    *(u32x4*)(rowp + bj * HALF) = w; } }
    }
};
struct EpiSwiGLU {
    static constexpr bool PERM = true, AFTER_DRAIN = false;
    bf16_t* O; int ldc;
    __device__ __forceinline__ void operator()(const f32x4 (&acc)[2][2][4][2], const Unit& u, int wr, int wc, int fr, int fq) const {
        const int row0 = u.pm * BM + wr * 64 + fr; const int col0 = u.pn * HALF + wc * 32 + 8 * fq;
#pragma unroll
        for (int ai = 0; ai < 2; ++ai)
#pragma unroll
            for (int m = 0; m < 4; ++m) { bf16_t* rowp = O + (size_t)(row0 + ai * HALF + m * 16) * ldc + col0;
                const f32x4 g0 = acc[ai][0][m][0], g1 = acc[ai][0][m][1], u0 = acc[ai][1][m][0], u1 = acc[ai][1][m][1];
                u32x4 w; w.x = cvt_pk_bf16(silu_f(g0[0]) * u0[0], silu_f(g0[1]) * u0[1]); w.y = cvt_pk_bf16(silu_f(g0[2]) * u0[2], silu_f(g0[3]) * u0[3]);
                w.z = cvt_pk_bf16(silu_f(g1[0]) * u1[0], silu_f(g1[1]) * u1[1]); w.w = cvt_pk_bf16(silu_f(g1[2]) * u1[2], silu_f(g1[3]) * u1[3]);
                *(u32x4*)rowp = w; }
    }
};
template <class Epi, class Sched, bool ALIGN_EPI = false, bool SP2 = false>
__device__ __forceinline__ void gemm_phase(PG8_LAS unsigned char* lds, const Gemm g, const Sched& S, const Epi& E) {
    int tid_l = threadIdx.x; asm volatile("" : "+v"(tid_l));
    const int tid = tid_l, wid = __builtin_amdgcn_readfirstlane(tid >> 6), lane = tid & 63, wr = wid >> 2, wc = wid & 3, fr = lane & 15, fq = lane >> 4;
    const int K = g.K, nt = K / BK;
    unsigned voffA[2], voffB[2];
#pragma unroll
    for (int i = 0; i < 2; ++i) { int R, C; stage_rc(tid * 16 + i * 8192, R, C); const int Rb = Epi::PERM ? ((R & ~31) + perm32(R & 31)) : R;
        voffA[i] = (unsigned)((size_t)R * g.a_row_bytes + (size_t)C * 2u); voffB[i] = (unsigned)(Rb * K + C) * 2u; }
    const size_t kstepB = (size_t)(BK * 2), kstepA = g.a_kstep_bytes;
    const size_t hstepB = (size_t)HALF * K * 2, hstepA = (size_t)HALF * g.a_row_bytes;
    const size_t tstepB = 2 * hstepB, tstepA = 2 * hstepA;
    const unsigned ldsw = (unsigned)wid * 1024u;
    const int aoff = lds_byte(wr * 64 + fr, fq * 8), boff = lds_byte(wc * 32 + fr, fq * 8);
#define PG8_SA(b, h) (((b) * 2 + (h)) * HTB)
#define PG8_SB(b, h) ((4 + (b) * 2 + (h)) * HTB)
#define PG8_STAGE(bufoff, gbase, voff) do { _Pragma("unroll") for (int _i = 0; _i < 2; ++_i) \
        __builtin_amdgcn_global_load_lds((const unsigned*)((const char*)(gbase) + (voff)[_i]), (PG8_LAS unsigned*)(lds + (bufoff) + ldsw + _i * 8192), 16, 0, 0); } while (0)
#define PG8_LDA(dst, b, h) do { _Pragma("unroll") for (int m = 0; m < 4; ++m) _Pragma("unroll") for (int k = 0; k < 2; ++k) dst[m][k] = *(const PG8_LAS bf16x8*)(lds + PG8_SA(b, h) + aoff + m * 2048 + k * 1024); } while (0)
#define PG8_LDB(dst, b, h) do { _Pragma("unroll") for (int n = 0; n < 2; ++n) _Pragma("unroll") for (int k = 0; k < 2; ++k) dst[n][k] = *(const PG8_LAS bf16x8*)(lds + PG8_SB(b, h) + boff + n * 2048 + k * 1024); } while (0)
#define PG8_MMA(ai, bj, At, Bt) do { __builtin_amdgcn_s_setprio(1); _Pragma("unroll") for (int m = 0; m < 4; ++m) _Pragma("unroll") for (int n = 0; n < 2; ++n) _Pragma("unroll") for (int k = 0; k < 2; ++k) \
        acc[ai][bj][m][n] = __builtin_amdgcn_mfma_f32_16x16x32_bf16(Bt[n][k], At[m][k], acc[ai][bj][m][n], 0, 0, 0); __builtin_amdgcn_s_setprio(0); } while (0)
#define PG8_WAIT_V(n) asm volatile("s_waitcnt vmcnt(" #n ")" ::: "memory")
#define PG8_WAIT_L(n) asm volatile("s_waitcnt lgkmcnt(" #n ")" ::: "memory")
#define PG8_BAR __builtin_amdgcn_s_barrier()
#define PG8_SCHED __builtin_amdgcn_sched_barrier(0)
    Unit cur, nxt; int ui = 0;
    if (!S.next(0, cur)) return;
    f32x4 acc[2][2][4][2];
#pragma unroll
    for (int a = 0; a < 2; ++a)
#pragma unroll
        for (int b = 0; b < 2; ++b)
#pragma unroll
            for (int m = 0; m < 4; ++m)
#pragma unroll
                for (int n = 0; n < 2; ++n) acc[a][b][m][n] = (f32x4){0.f, 0.f, 0.f, 0.f};
    bf16x8 At[4][2], B0[2][2], B1[2][2];
    const char* cA = (const char*)g.A + (size_t)cur.pm * tstepA; const char* cB = (const char*)g.Bt + (size_t)cur.pn * tstepB;
    S.a_ready(cur);
    if constexpr (SP2) {
        PG8_STAGE(PG8_SB(0, 0), cB, voffB); PG8_STAGE(PG8_SB(0, 1), cB + hstepB, voffB); PG8_STAGE(PG8_SA(0, 0), cA, voffA); PG8_STAGE(PG8_SA(0, 1), cA + hstepA, voffA);
        if (wr == 1) PG8_BAR;
        PG8_WAIT_V(2); PG8_BAR;
        PG8_STAGE(PG8_SB(1, 0), cB + kstepB, voffB); PG8_STAGE(PG8_SA(1, 0), cA + kstepA, voffA); PG8_STAGE(PG8_SB(1, 1), cB + hstepB + kstepB, voffB);
        PG8_WAIT_V(6); PG8_BAR;
    } else {
        PG8_STAGE(PG8_SB(0, 0), cB, voffB); PG8_STAGE(PG8_SA(0, 0), cA, voffA); PG8_STAGE(PG8_SB(0, 1), cB + hstepB, voffB); PG8_STAGE(PG8_SA(0, 1), cA + hstepA, voffA);
        if (wr == 1) PG8_BAR;
        PG8_WAIT_V(4); PG8_BAR;
        PG8_STAGE(PG8_SB(1, 0), cB + kstepB, voffB); PG8_STAGE(PG8_SA(1, 0), cA + kstepA, voffA); PG8_STAGE(PG8_SB(1, 1), cB + hstepB + kstepB, voffB);
        PG8_WAIT_V(6); PG8_BAR;
    }
    for (;;) {
        const bool has_next = S.next(ui + 1, nxt);
        const char* nA = has_next ? (const char*)g.A + (size_t)nxt.pm * tstepA : cA; const char* nB = has_next ? (const char*)g.Bt + (size_t)nxt.pn * tstepB : cB;
        for (int t = 0; t < nt; t += 2) {
            const bool last = (t == nt - 2);
            const char* a1 = cA + (size_t)(t + 1) * kstepA;
            const char* a2 = last ? nA : cA + (size_t)(t + 2) * kstepA; const char* b2 = last ? nB : cB + (size_t)(t + 2) * kstepB;
            const char* a3 = a2 + kstepA; const char* b3 = b2 + kstepB;
            if (last && has_next) S.a_ready(nxt);
            if constexpr (SP2) {
            PG8_LDB(B0, 0, 0); PG8_LDB(B1, 0, 1); PG8_SCHED; PG8_LDA(At, 0, 0); PG8_STAGE(PG8_SA(1, 1), a1 + hstepA, voffA);
            PG8_WAIT_V(8); PG8_WAIT_L(0); PG8_BAR; PG8_MMA(0, 0, At, B0); PG8_MMA(0, 1, At, B1); PG8_BAR; PG8_SCHED;
            PG8_LDA(At, 0, 1); PG8_STAGE(PG8_SB(0, 0), b2, voffB); PG8_STAGE(PG8_SB(0, 1), b2 + hstepB, voffB); PG8_STAGE(PG8_SA(0, 0), a2, voffA);
            PG8_WAIT_V(8); PG8_WAIT_L(0); PG8_BAR; PG8_MMA(1, 0, At, B0); PG8_MMA(1, 1, At, B1); PG8_BAR; PG8_SCHED;
            PG8_LDB(B0, 1, 0); PG8_LDB(B1, 1, 1); PG8_SCHED; PG8_LDA(At, 1, 0); PG8_STAGE(PG8_SA(0, 1), a2 + hstepA, voffA);
            PG8_WAIT_V(8); PG8_WAIT_L(0); PG8_BAR; PG8_MMA(0, 0, At, B0); PG8_MMA(0, 1, At, B1); PG8_BAR; PG8_SCHED;
            PG8_LDA(At, 1, 1); PG8_STAGE(PG8_SB(1, 0), b3, voffB); PG8_STAGE(PG8_SB(1, 1), b3 + hstepB, voffB); PG8_STAGE(PG8_SA(1, 0), a3, voffA);
            PG8_WAIT_V(8); PG8_WAIT_L(0); PG8_BAR; PG8_MMA(1, 0, At, B0); PG8_MMA(1, 1, At, B1); PG8_BAR; PG8_SCHED;
            } else {
            PG8_LDB(B0, 0, 0); PG8_SCHED; PG8_LDA(At, 0, 0); PG8_STAGE(PG8_SA(1, 1), a1 + hstepA, voffA);
            PG8_WAIT_L(8); PG8_BAR; PG8_WAIT_L(0); PG8_MMA(0, 0, At, B0); PG8_BAR; PG8_SCHED;
            PG8_LDB(B1, 0, 1); PG8_STAGE(PG8_SB(0, 0), b2, voffB);
            PG8_BAR; PG8_WAIT_L(0); PG8_MMA(0, 1, At, B1); PG8_BAR;
            PG8_LDA(At, 0, 1); PG8_STAGE(PG8_SA(0, 0), a2, voffA);
            PG8_BAR; PG8_WAIT_L(0); PG8_MMA(1, 0, At, B0); PG8_BAR; PG8_SCHED;
            PG8_STAGE(PG8_SB(0, 1), b2 + hstepB, voffB);
            PG8_WAIT_V(6); PG8_BAR; PG8_MMA(1, 1, At, B1); PG8_BAR;
            PG8_LDB(B0, 1, 0); PG8_SCHED; PG8_LDA(At, 1, 0); PG8_STAGE(PG8_SA(0, 1), a2 + hstepA, voffA);
            PG8_WAIT_L(8); PG8_BAR; PG8_WAIT_L(0); PG8_MMA(0, 0, At, B0); PG8_BAR; PG8_SCHED;
            PG8_LDB(B1, 1, 1); PG8_STAGE(PG8_SB(1, 0), b3, voffB);
            PG8_BAR; PG8_WAIT_L(0); PG8_MMA(0, 1, At, B1); PG8_BAR;
            PG8_LDA(At, 1, 1); PG8_STAGE(PG8_SA(1, 0), a3, voffA);
            PG8_BAR; PG8_WAIT_L(0); PG8_MMA(1, 0, At, B0); PG8_BAR; PG8_SCHED;
            PG8_STAGE(PG8_SB(1, 1), b3 + hstepB, voffB);
            PG8_WAIT_V(6); PG8_BAR; PG8_MMA(1, 1, At, B1); PG8_BAR;
            }
        }
        if constexpr (ALIGN_EPI) { if (wr == 0) PG8_BAR; }
        if constexpr (!Epi::AFTER_DRAIN) { E(acc, cur, wr, wc, fr, fq); S.done(cur); }
        if (!has_next) break;
#pragma unroll
        for (int a = 0; a < 2; ++a)
#pragma unroll
            for (int b = 0; b < 2; ++b)
#pragma unroll
                for (int m = 0; m < 4; ++m)
#pragma unroll
                    for (int n = 0; n < 2; ++n) acc[a][b][m][n] = (f32x4){0.f, 0.f, 0.f, 0.f};
        cur = nxt; cA = nA; cB = nB; ++ui;
        if constexpr (ALIGN_EPI) { if (wr == 1) PG8_BAR; }
    }
    PG8_WAIT_V(0);
    if constexpr (!ALIGN_EPI) { if (wr == 0) PG8_BAR; }
    PG8_BAR;
    if constexpr (Epi::AFTER_DRAIN) { E.fused(acc, cur, wr, wc, fr, fq, lds, wid, lane); S.done(cur); }
#undef PG8_SA
#undef PG8_SB
#undef PG8_STAGE
#undef PG8_LDA
#undef PG8_LDB
#undef PG8_MMA
#undef PG8_WAIT_V
#undef PG8_WAIT_L
#undef PG8_BAR
#undef PG8_SCHED
}
}
constexpr int NWAVES = 8;
constexpr int BATCH = 2, SEQ = 16384, DM = 1024, DEPTH = 2, M = BATCH * SEQ, HD = 64;
constexpr int INW = 2188, INP = 2304, DFF = 2816, NGU = 2 * DFF;
constexpr int C_NQ = 0, C_KC = 256, C_VC = 320, C_KS = 384, C_VS = 448, C_KW = 512, C_VW = 576, C_SQ = 640, C_SK = 1152, C_SV = 1280, C_BQ = 1408, C_BK = 1664, C_BV = 1920, C_NG = 2176;
constexpr int NCP = 1024;
constexpr float RMS_EPS = 1e-6f;
constexpr int NPH = 1 + 11 * DEPTH;

constexpr size_t MiB = 1u << 20;
constexpr size_t WS_CTL = 0, CTL_ZERO_BYTES = 1 * MiB;
constexpr size_t WS_WIN = 2 * MiB, WS_WOUT = 11 * MiB, WS_WGU = 15 * MiB, WS_WDN = 37 * MiB, WS_W1 = 48 * MiB, WS_POSB = 52 * MiB, WS_KVC = 53 * MiB, WS_HIDC = 54 * MiB;
constexpr size_t WS_XN = 64 * MiB, WS_PROJ = 128 * MiB, WS_HID = 128 * MiB, WS_IMP = 272 * MiB;
constexpr size_t WS_OCMP = 304 * MiB, WS_OSLC = 336 * MiB, WS_OWIN = 368 * MiB, WS_OSWA = 400 * MiB, WS_OSB = 464 * MiB, WS_F = 304 * MiB, WS_END = 496 * MiB;
static_assert(WS_WIN + (size_t)DEPTH * INP * DM * 2 <= WS_WOUT && WS_WOUT + (size_t)DEPTH * DM * DM * 2 <= WS_WGU && WS_WGU + (size_t)DEPTH * NGU * DM * 2 <= WS_WDN && WS_WDN + (size_t)DEPTH * DM * DFF * 2 <= WS_W1 && WS_W1 + (size_t)DEPTH * 2 * 256 * 2048 * 2 <= WS_POSB, "weights map");
static_assert(WS_PROJ + (size_t)M * INP * 2 <= WS_IMP && WS_HID + (size_t)M * DFF * 2 <= WS_OCMP && WS_IMP + (size_t)M * 256 * 4 <= WS_OCMP && WS_OSB + (size_t)M * 256 * 4 <= WS_END, "activation map");
constexpr int CW_BAR = 4096;

constexpr int RING_OFF = 0, RING_BYTES = 131072;
constexpr int LDSCTL_OFF = RING_BYTES, MISC_OFF = LDSCTL_OFF + 320;
constexpr int LDS_BYTES = 147456;

#define GAS __attribute__((address_space(1)))
#define LAS __attribute__((address_space(3)))
typedef unsigned short bf16;
typedef unsigned v4u __attribute__((ext_vector_type(4)));
typedef unsigned v2u __attribute__((ext_vector_type(2)));
typedef float f32x4 __attribute__((ext_vector_type(4)));
typedef GAS unsigned gu32;
#define LDS_WAIT() asm volatile("s_waitcnt lgkmcnt(0)" ::: "memory")
#define VM_WAIT() asm volatile("s_waitcnt vmcnt(0)" ::: "memory")
__device__ __forceinline__ unsigned f2bf(float f) { unsigned u = __builtin_bit_cast(unsigned, f); return (u + 0x7fffu + ((u >> 16) & 1u)) >> 16; }
__device__ __forceinline__ unsigned pk2(float lo, float hi) { return f2bf(lo) | (f2bf(hi) << 16); }
__device__ __forceinline__ float bf_lo(unsigned u) { return __uint_as_float(u << 16); }
__device__ __forceinline__ float bf_hi(unsigned u) { return __uint_as_float(u & 0xffff0000u); }
__device__ __forceinline__ float bf1(bf16 b) { return __uint_as_float(((unsigned)b) << 16); }

#define XB_TMO      128
#define XB_XCNT(j)  (256  + 64 * (j))
#define XB_XSUB(j)  (1280 + 64 * (j))
#define XB_XGEN(j)  (2304 + 64 * (j))
#define XB_TOP      3328
#define XB_TOPGEN   3392
#define XCD_BAR_WORDS 3456
#define XB_SPIN_CAP (1u << 18)
__device__ __forceinline__ unsigned xb_ld(unsigned* p)              { return __hip_atomic_load(p, __ATOMIC_RELAXED, __HIP_MEMORY_SCOPE_AGENT); }
__device__ __forceinline__ unsigned xb_add(unsigned* p, unsigned v) { return __hip_atomic_fetch_add(p, v, __ATOMIC_RELAXED, __HIP_MEMORY_SCOPE_AGENT); }
__device__ __forceinline__ unsigned xb_xcc_id() { return (unsigned)__builtin_amdgcn_s_getreg((3 << 11) | 20) & 0xFu; }
#define XB_SPIN(cond, bar) do { unsigned _sp = 0; while (cond) { __builtin_amdgcn_s_sleep(1); \
    if ((++_sp & 255u) == 0u) { if (xb_ld(&(bar)[XB_TMO])) break; if (_sp > XB_SPIN_CAP) { atomicAdd(&(bar)[XB_TMO], 1u); break; } } } } while (0)
struct XcdBarrier { unsigned* bar; unsigned x; volatile LAS unsigned* st; };
__device__ __forceinline__ XcdBarrier xcd_barrier_post(unsigned* bar, volatile LAS unsigned* st) {
    XcdBarrier b; b.bar = bar; b.x = xb_xcc_id(); b.st = st;
    if (threadIdx.x == 0) (void)xb_add(&bar[XB_XCNT(b.x)], 1u);
    return b;
}
__device__ __forceinline__ void xcd_barrier_complete(unsigned* bar, unsigned x, unsigned& nloc, unsigned& nx) {
    const unsigned G = gridDim.x * gridDim.y * gridDim.z;
    unsigned sum, cnt, mine, sp = 0u;
    for (;;) {
        sum = 0u; cnt = 0u; mine = 0u;
#pragma unroll
        for (unsigned j = 0; j < 16; ++j) { const unsigned c = xb_ld(&bar[XB_XCNT(j)]); sum += c; cnt += (c > 0u) ? 1u : 0u; mine = (j == x) ? c : mine; }
        if (sum == G) break;
        __builtin_amdgcn_s_sleep(1);
        if ((++sp & 255u) == 0u) { if (xb_ld(&bar[XB_TMO])) break; if (sp > XB_SPIN_CAP) { atomicAdd(&bar[XB_TMO], 1u); break; } }
    }
    nloc = mine > 0u ? mine : 1u; nx = cnt > 0u ? cnt : 1u;
}
__device__ __forceinline__ void xcd_barrier(const XcdBarrier& b) {
    asm volatile("s_waitcnt vmcnt(0)" ::: "memory");
    __syncthreads();
    if (threadIdx.x == 0) {
        unsigned* bar = b.bar;
        __builtin_amdgcn_s_waitcnt(0);
        unsigned nloc = b.st[0], nx = b.st[1];
        if (nloc == 0u) { xcd_barrier_complete(bar, b.x, nloc, nx); b.st[0] = nloc; b.st[1] = nx; }
        const unsigned old = xb_add(&bar[XB_XSUB(b.x)], 1u);
        const unsigned gen = old / nloc;
        if (old + 1u == (gen + 1u) * nloc) {
            __builtin_amdgcn_fence(__ATOMIC_RELEASE, "agent");
            asm volatile("s_waitcnt vmcnt(0)" ::: "memory");
            const unsigned og = xb_add(&bar[XB_TOP], 1u);
            const unsigned tg = og / nx;
            if (og + 1u == (tg + 1u) * nx) xb_add(&bar[XB_TOPGEN], 1u);
            else XB_SPIN(xb_ld(&bar[XB_TOPGEN]) == tg, bar);
            __builtin_amdgcn_fence(__ATOMIC_ACQUIRE, "agent");
            xb_add(&bar[XB_XGEN(b.x)], 1u);
            asm volatile("s_waitcnt vmcnt(0)" ::: "memory");
        } else {
            XB_SPIN(xb_ld(&bar[XB_XGEN(b.x)]) == gen, bar);
            __builtin_amdgcn_fence(__ATOMIC_ACQUIRE, "agent");
            asm volatile("s_waitcnt vmcnt(0)" ::: "memory");
        }
    }
    __syncthreads();
}

__device__ __forceinline__ float wave_sum(float v) {
#pragma unroll
    for (int o = 1; o < 64; o <<= 1) v += __shfl_xor(v, o);
    return v;
}
__device__ __forceinline__ int t5_bucket(int n) {
    n = n < 0 ? 0 : n;
    if (n < 16) return n;
    const int e = 31 - __clz(n);
    const unsigned nn = (unsigned)n * (unsigned)n;
    const int f = 2 * e + ((nn >> (2 * e + 1)) ? 1 : 0);
    const int b = f + 8;
    return b > 31 ? 31 : b;
}
__device__ __forceinline__ void load_row_bf16(float (&q)[64], const bf16* p) {
    const v4u* p4 = (const v4u*)p;
#pragma unroll
    for (int c = 0; c < 8; ++c) { const v4u w = p4[c];
        q[8 * c + 0] = bf_lo(w.x); q[8 * c + 1] = bf_hi(w.x); q[8 * c + 2] = bf_lo(w.y); q[8 * c + 3] = bf_hi(w.y);
        q[8 * c + 4] = bf_lo(w.z); q[8 * c + 5] = bf_hi(w.z); q[8 * c + 6] = bf_lo(w.w); q[8 * c + 7] = bf_hi(w.w); }
}
__device__ __forceinline__ float dot64(const float (&q)[64], const bf16* p) {
    const v4u* p4 = (const v4u*)p; float s0 = 0.f, s1 = 0.f;
#pragma unroll
    for (int c = 0; c < 8; ++c) { const v4u w = p4[c];
        s0 = fmaf(q[8 * c + 0], bf_lo(w.x), s0); s1 = fmaf(q[8 * c + 1], bf_hi(w.x), s1); s0 = fmaf(q[8 * c + 2], bf_lo(w.y), s0); s1 = fmaf(q[8 * c + 3], bf_hi(w.y), s1);
        s0 = fmaf(q[8 * c + 4], bf_lo(w.z), s0); s1 = fmaf(q[8 * c + 5], bf_hi(w.z), s1); s0 = fmaf(q[8 * c + 6], bf_lo(w.w), s0); s1 = fmaf(q[8 * c + 7], bf_hi(w.w), s1); }
    return s0 + s1;
}
__device__ __forceinline__ void axpy64(float (&acc)[64], float p, const bf16* vp) {
    const v4u* p4 = (const v4u*)vp;
#pragma unroll
    for (int c = 0; c < 8; ++c) { const v4u w = p4[c];
        acc[8 * c + 0] = fmaf(p, bf_lo(w.x), acc[8 * c + 0]); acc[8 * c + 1] = fmaf(p, bf_hi(w.x), acc[8 * c + 1]); acc[8 * c + 2] = fmaf(p, bf_lo(w.y), acc[8 * c + 2]); acc[8 * c + 3] = fmaf(p, bf_hi(w.y), acc[8 * c + 3]);
        acc[8 * c + 4] = fmaf(p, bf_lo(w.z), acc[8 * c + 4]); acc[8 * c + 5] = fmaf(p, bf_hi(w.z), acc[8 * c + 5]); acc[8 * c + 6] = fmaf(p, bf_lo(w.w), acc[8 * c + 6]); acc[8 * c + 7] = fmaf(p, bf_hi(w.w), acc[8 * c + 7]); }
}
__device__ __forceinline__ float dot64f(const float (&q)[64], const float* p) {
    const f32x4* p4 = (const f32x4*)p; float s0 = 0.f, s1 = 0.f;
#pragma unroll
    for (int c = 0; c < 16; ++c) { const f32x4 w = p4[c]; s0 = fmaf(q[4 * c + 0], w.x, s0); s1 = fmaf(q[4 * c + 1], w.y, s1); s0 = fmaf(q[4 * c + 2], w.z, s0); s1 = fmaf(q[4 * c + 3], w.w, s1); }
    return s0 + s1;
}
__device__ __forceinline__ void axpy64f(float (&acc)[64], float p, const float* vp) {
    const f32x4* p4 = (const f32x4*)vp;
#pragma unroll
    for (int c = 0; c < 16; ++c) { const f32x4 w = p4[c]; acc[4 * c + 0] = fmaf(p, w.x, acc[4 * c + 0]); acc[4 * c + 1] = fmaf(p, w.y, acc[4 * c + 1]); acc[4 * c + 2] = fmaf(p, w.z, acc[4 * c + 2]); acc[4 * c + 3] = fmaf(p, w.w, acc[4 * c + 3]); }
}
__device__ __forceinline__ void store_row_f32(float* o, const float (&acc)[64], float sc) {
    f32x4* o4 = (f32x4*)o;
#pragma unroll
    for (int c = 0; c < 16; ++c) o4[c] = (f32x4){acc[4 * c] * sc, acc[4 * c + 1] * sc, acc[4 * c + 2] * sc, acc[4 * c + 3] * sc};
}
__device__ __forceinline__ void rms_row_to_bf16(const float* xrow, const float* g, bf16* orow, int lane) {
    const f32x4* xr = (const f32x4*)xrow + lane; f32x4 v[4]; float s = 0.f;
#pragma unroll
    for (int j = 0; j < 4; ++j) { v[j] = xr[64 * j]; s += (v[j].x * v[j].x + v[j].y * v[j].y) + (v[j].z * v[j].z + v[j].w * v[j].w); }
    const float rstd = rsqrtf(wave_sum(s) * (1.f / DM) + RMS_EPS);
    const f32x4* gr = (const f32x4*)g + lane; v2u* o8 = (v2u*)orow + lane;
#pragma unroll
    for (int j = 0; j < 4; ++j) { const f32x4 gv = gr[64 * j]; v2u w; w.x = pk2(v[j].x * rstd * gv.x, v[j].y * rstd * gv.y); w.y = pk2(v[j].z * rstd * gv.z, v[j].w * rstd * gv.w); o8[64 * j] = w; }
}

struct Args { const float* in[17]; float* out; unsigned char* ws; int ph_lo, ph_hi, li, pad; };
enum { I_X = 0, I_RELB, I_LNAP, I_WIN, I_POS, I_W1, I_B1, I_W2, I_SINK, I_GRPG, I_WOUT, I_LNAPOST, I_LNFP, I_WG, I_WU, I_WD, I_LNFPOST };

__device__ __forceinline__ void p0_prologue(const Args& a, LAS unsigned char* lds, int tid, int lane, int wave) {
    unsigned char* ws = a.ws;
    LAS float* tile = (LAS float*)lds;
    for (int it = blockIdx.x; it < 6400; it += gridDim.x) {
        const int l = it / 3200; int r = it % 3200;
        const int nl = tid & 63;
        const float* W; int ldw, Kd, kt, nt, col; bf16* dst;
        if (r < 576) { kt = r / 36; nt = r % 36; const int n = nt * 64 + nl; W = a.in[I_WIN] + (size_t)l * DM * INW; ldw = INW; Kd = DM;
            col = n < 640 ? n : (n < 2176 ? n + 12 : (n < 2188 ? n - 2176 + 640 : -1)); dst = (bf16*)(ws + WS_WIN) + (size_t)l * INP * DM; }
        else if (r < 832) { r -= 576; kt = r / 16; nt = r % 16; W = a.in[I_WOUT] + (size_t)l * DM * DM; ldw = DM; Kd = DM; col = nt * 64 + nl; dst = (bf16*)(ws + WS_WOUT) + (size_t)l * DM * DM; }
        else if (r < 2240) { r -= 832; kt = r / 88; nt = r % 88; const int n = nt * 64 + nl, t = n >> 7; W = ((t & 1) ? a.in[I_WU] : a.in[I_WG]) + (size_t)l * DM * DFF; ldw = DFF; Kd = DM;
            col = (t >> 1) * 128 + (n & 127); dst = (bf16*)(ws + WS_WGU) + (size_t)l * NGU * DM; }
        else if (r < 2944) { r -= 2240; kt = r / 16; nt = r % 16; W = a.in[I_WD] + (size_t)l * DFF * DM; ldw = DM; Kd = DFF; col = nt * 64 + nl; dst = (bf16*)(ws + WS_WDN) + (size_t)l * DM * DFF; }
        else { r -= 2944; const int kv = r / 128; r %= 128; kt = r / 4; nt = r % 4; W = a.in[I_W1] + (size_t)(l * 2 + kv) * 2048 * 256; ldw = 256; Kd = 2048; col = nt * 64 + nl;
            dst = (bf16*)(ws + WS_W1) + (size_t)(l * 2 + kv) * 256 * 2048; }
#pragma unroll
        for (int i = 0; i < 8; ++i) { const int k = i * 8 + (tid >> 6); tile[k * 65 + nl] = col >= 0 ? W[(size_t)(kt * 64 + k) * ldw + col] : 0.f; }
        __syncthreads();
        { const int rr = tid >> 3, c = tid & 7; const LAS float* s = tile + (8 * c) * 65 + rr;
          v4u o; o.x = pk2(s[0 * 65], s[1 * 65]); o.y = pk2(s[2 * 65], s[3 * 65]); o.z = pk2(s[4 * 65], s[5 * 65]); o.w = pk2(s[6 * 65], s[7 * 65]);
          *(v4u*)(dst + (size_t)(nt * 64 + rr) * Kd + kt * 64 + 8 * c) = o; }
        __syncthreads();
    }
    const int gw = blockIdx.x * NWAVES + wave, NGW = gridDim.x * NWAVES;
    for (int o = gw; o < DEPTH * 2 * 256; o += NGW) { const int lk = o >> 8, n = o & 255; float s = 0.f;
        const float* pos = a.in[I_POS] + (size_t)lk * 2048; const float* w1 = a.in[I_W1] + (size_t)lk * 2048 * 256 + n;
#pragma unroll 8
        for (int i = 0; i < 32; ++i) { const int k = lane + 64 * i; s = fmaf(pos[k], w1[(size_t)k * 256], s); }
        s = wave_sum(s);
        if (lane == 0) ((float*)(ws + WS_POSB))[o] = s + a.in[I_B1][o]; }
    for (int m = gw; m < M; m += NGW) rms_row_to_bf16(a.in[I_X] + (size_t)m * DM, a.in[I_LNAP], (bf16*)(ws + WS_XN) + (size_t)m * DM, lane);
}

__device__ __forceinline__ void p_compress2(const Args& a, int l, int tid) {
    const bf16* hid = (const bf16*)(a.ws + WS_HIDC); float* kvc = (float*)(a.ws + WS_KVC);
    const int NT = gridDim.x * NWAVES * 64;
    for (int idx = blockIdx.x * NWAVES * 64 + tid; idx < 2 * 2048 * 64; idx += NT) {
        const int d = idx & 63, m = (idx >> 6) & 2047, kv = idx >> 17;
        const float* w2 = a.in[I_W2] + (size_t)(l * 2 + kv) * 256 * 64 + d; const bf16* hr = hid + ((size_t)kv * 2048 + m) * 256; float s = 0.f;
#pragma unroll 8
        for (int n = 0; n < 256; ++n) s = fmaf(bf1(hr[n]), w2[n * 64], s);
        kvc[idx] = s;
    }
}

__device__ __forceinline__ void cmp_item(const Args& a, int it, int lane, const LAS float* tab) {
    const bf16* PROJ = (const bf16*)(a.ws + WS_PROJ); const float* KC = (const float*)(a.ws + WS_KVC); const float* VC = KC + 2048 * 64;
    float* OCMP = (float*)(a.ws + WS_OCMP); float* IMP = (float*)(a.ws + WS_IMP);
    const int tl = lane >> 2, h = lane & 3, tok = it * 16 + tl, t = tok & (SEQ - 1);
    const int t0 = __builtin_amdgcn_readfirstlane((it * 16) & (SEQ - 1)), b = __builtin_amdgcn_readfirstlane((it * 16) >> 14);
    float q[64]; load_row_bf16(q, PROJ + (size_t)tok * INP + C_NQ + h * 64);
    const int nc_it = (t0 + 15 >= 31) ? ((t0 + 15 - 31) >> 4) + 1 : 0;
    const float* kcb = KC + (size_t)b * NCP * 64; const float* vcb = VC + (size_t)b * NCP * 64;
    float m = -INFINITY, lsum = 0.f;
    for (int c = 0; c < nc_it; ++c) {
        const int dist = t - (16 * c + 31);
        const float z = dot64f(q, kcb + (size_t)c * 64) * 0.125f + tab[t5_bucket(dist) * 12 + h];
        if (dist >= 0) { const float mn = fmaxf(m, z); lsum = lsum * __expf(m - mn) + __expf(z - mn); m = mn; }
    }
    const float inv_l = lsum > 0.f ? 1.f / lsum : 0.f;
    float acc[64];
#pragma unroll
    for (int d = 0; d < 64; ++d) acc[d] = 0.f;
    float cur = 0.f;
    for (int c = 0; c < nc_it; ++c) {
        const int dist = t - (16 * c + 31);
        const float z = dot64f(q, kcb + (size_t)c * 64) * 0.125f + tab[t5_bucket(dist) * 12 + h];
        const float p = dist >= 0 ? __expf(z - m) * inv_l : 0.f;
        axpy64f(acc, p, vcb + (size_t)c * 64);
        float ps = p + __shfl_xor(p, 1); ps += __shfl_xor(ps, 2);
        if ((c & 3) < 3) cur += ps; else { cur += 0.5f * ps; if (h == 0) IMP[(size_t)tok * 256 + (c >> 2)] = cur; cur = 0.5f * ps; }
    }
    store_row_f32(OCMP + (size_t)tok * 256 + h * 64, acc, 1.f);
}
template <int WIN> __device__ __forceinline__ void band_item(const bf16* PROJ, int tok0, int lane, int cq, int ck, int cv, const LAS float* tab, int bh, bool has_sink, float sink, float* out) {
    const int tok = tok0 + lane, t = tok & (SEQ - 1);
    const int t0 = __builtin_amdgcn_readfirstlane(tok0 & (SEQ - 1)); const size_t rb = (size_t)__builtin_amdgcn_readfirstlane(tok0 - (tok0 & (SEQ - 1)));
    float q[64]; load_row_bf16(q, PROJ + (size_t)tok * INP + cq);
    float acc[64];
#pragma unroll
    for (int d = 0; d < 64; ++d) acc[d] = 0.f;
    float m = has_sink ? sink : -INFINITY, lsum = has_sink ? 1.f : 0.f;
    const int s_lo = t0 - (WIN - 1) > 0 ? t0 - (WIN - 1) : 0;
    for (int s = s_lo; s <= t0 + 63; ++s) {
        const bf16* row = PROJ + (rb + (size_t)s) * INP;
        const int dist = t - s;
        float z = dot64(q, row + ck) * 0.125f;
        if (dist >= 0 && dist < WIN) {
            z += tab[t5_bucket(dist) * 12 + bh];
            if (z > m) { const float sc = __expf(m - z); lsum *= sc;
#pragma unroll
                for (int d = 0; d < 64; ++d) acc[d] *= sc;
                m = z; }
            const float p = __expf(z - m); lsum += p; axpy64(acc, p, row + cv);
        }
    }
    store_row_f32(out, acc, 1.f / lsum);
}
__device__ __forceinline__ void sb_item(const bf16* PROJ, int tok0, int lane, int h, float* out) {
    const int tok = tok0 + lane, t = tok & (SEQ - 1);
    const int t0 = __builtin_amdgcn_readfirstlane(tok0 & (SEQ - 1)); const size_t rb = (size_t)__builtin_amdgcn_readfirstlane(tok0 - (tok0 & (SEQ - 1)));
    float q[64]; load_row_bf16(q, PROJ + (size_t)tok * INP + C_BQ + h * 64);
    float acc[64];
#pragma unroll
    for (int d = 0; d < 64; ++d) acc[d] = 0.f;
    float later = 0.f;
    for (int s = t0 + 62; s >= 0; --s) {
        const bf16* row = PROJ + (rb + (size_t)s) * INP;
        const float z = dot64(q, row + C_BK + h * 64) * 0.125f;
        if (s < t) {
            const float sp = fmaxf(z, 0.f) + __logf(1.f + __expf(-fabsf(z)));
            const float aw = __expf(z - sp + later);
            axpy64(acc, aw, row + C_BV + h * 64);
            later -= sp;
        }
        if (s < t0 && __all(later < -104.f)) break;
    }
    store_row_f32(out, acc, 1.f);
}
__device__ __forceinline__ void p_attn_a(const Args& a, int l, LAS unsigned char* lds, int tid, int lane, int wave) {
    LAS float* tab = (LAS float*)lds;
    if (tid < 384) tab[tid] = a.in[I_RELB][tid];
    __syncthreads();
    const bf16* PROJ = (const bf16*)(a.ws + WS_PROJ);
    const int gw = blockIdx.x * NWAVES + wave, NGW = gridDim.x * NWAVES;
    for (int it = gw; it < M / 16; it += NGW) cmp_item(a, (M / 16 - 1) - it, lane, tab);
    for (int it = gw; it < (M / 64) * 4; it += NGW) { const int tile = it >> 2, h = it & 3;
        band_item<512>(PROJ, tile * 64, lane, C_NQ + h * 64, C_KW, C_VW, tab, h, false, 0.f, (float*)(a.ws + WS_OWIN) + (size_t)(tile * 64 + lane) * 256 + h * 64); }
    for (int it = gw; it < (M / 64) * 8; it += NGW) { const int tile = it >> 3, hq = it & 7;
        band_item<128>(PROJ, tile * 64, lane, C_SQ + hq * 64, C_SK + (hq >> 2) * 64, C_SV + (hq >> 2) * 64, tab, 4 + hq, true, a.in[I_SINK][l * 8 + hq], (float*)(a.ws + WS_OSWA) + (size_t)(tile * 64 + lane) * 512 + hq * 64); }
    for (int it = gw; it < (M / 64) * 4; it += NGW) { const int tile = it >> 2, h = it & 3;
        sb_item(PROJ, tile * 64, lane, h, (float*)(a.ws + WS_OSB) + (size_t)(tile * 64 + lane) * 256 + h * 64); }
}
__device__ __forceinline__ void p_attn_b(const Args& a, LAS unsigned char* lds, int tid, int lane, int wave) {
    LAS float* tab = (LAS float*)lds; LAS int* idxL = (LAS int*)(lds + 2048) + wave * 256;
    if (tid < 384) tab[tid] = a.in[I_RELB][tid];
    __syncthreads();
    const bf16* PROJ = (const bf16*)(a.ws + WS_PROJ); const float* IMP = (const float*)(a.ws + WS_IMP); float* OSLC = (float*)(a.ws + WS_OSLC);
    const int gw = blockIdx.x * NWAVES + wave, NGW = gridDim.x * NWAVES;
    for (int it = gw; it < M / 16; it += NGW) {
        for (int tl = 0; tl < 16; ++tl) {
            const int tok = it * 16 + tl, t = tok & (SEQ - 1), cur = t >> 6;
            int my = -1;
            if (cur <= 15) { my = lane <= cur ? lane : -1; }
            else {
                float v[4];
#pragma unroll
                for (int i = 0; i < 4; ++i) { const int j = lane + 64 * i; v[i] = (j >= 1 && j <= cur - 2) ? IMP[(size_t)tok * 256 + j] : -INFINITY; }
                if (lane == 0) my = 0; else if (lane == 1) my = cur - 1; else if (lane == 2) my = cur;
                for (int r = 0; r < 13; ++r) {
                    float bv = v[0]; int bj = lane;
#pragma unroll
                    for (int i = 1; i < 4; ++i) if (v[i] > bv) { bv = v[i]; bj = lane + 64 * i; }
#pragma unroll
                    for (int o = 1; o < 64; o <<= 1) { const float ov = __shfl_xor(bv, o); const int oj = __shfl_xor(bj, o); if (ov > bv || (ov == bv && oj < bj)) { bv = ov; bj = oj; } }
                    if (lane == 3 + r) my = bj;
#pragma unroll
                    for (int i = 0; i < 4; ++i) if (lane + 64 * i == bj) v[i] = -INFINITY;
                }
            }
            if (lane < 16) idxL[tl * 16 + lane] = my;
        }
        LDS_WAIT();
        const int tl = lane >> 2, h = lane & 3, tok = it * 16 + tl, t = tok & (SEQ - 1);
        const size_t rb = (size_t)((it * 16) - ((it * 16) & (SEQ - 1)));
        float q[64]; load_row_bf16(q, PROJ + (size_t)tok * INP + C_NQ + h * 64);
        float acc[64];
#pragma unroll
        for (int d = 0; d < 64; ++d) acc[d] = 0.f;
        float m = -INFINITY, lsum = 0.f;
        for (int k = 0; k < 16; ++k) {
            const int blk = idxL[tl * 16 + k];
            for (int kk = 0; kk < 64; ++kk) {
                const int pos = blk * 64 + kk;
                if (blk >= 0 && pos <= t) {
                    const bf16* row = PROJ + (rb + (size_t)pos) * INP;
                    const float z = dot64(q, row + C_KS) * 0.125f + tab[t5_bucket(t - pos) * 12 + h];
                    if (z > m) { const float sc = __expf(m - z); lsum *= sc;
#pragma unroll
                        for (int d = 0; d < 64; ++d) acc[d] *= sc;
                        m = z; }
                    const float p = __expf(z - m); lsum += p; axpy64(acc, p, row + C_VS);
                }
            }
        }
        store_row_f32(OSLC + (size_t)tok * 256 + h * 64, acc, 1.f / lsum);
        LDS_WAIT();
    }
}
__device__ __forceinline__ void p_groupnorm(const Args& a, int l, int lane, int wave) {
    const bf16* PROJ = (const bf16*)(a.ws + WS_PROJ); bf16* MIX = (bf16*)(a.ws + WS_XN); const float* gg = a.in[I_GRPG] + (size_t)l * DM;
    const int gw = blockIdx.x * NWAVES + wave, NGW = gridDim.x * NWAVES;
    for (int tok = gw; tok < M; tok += NGW) {
        const int hd = lane >> 4; const bf16* gl = PROJ + (size_t)tok * INP + C_NG;
        const float g0 = 1.f / (1.f + __expf(-bf1(gl[hd]))), g1 = 1.f / (1.f + __expf(-bf1(gl[4 + hd]))), g2 = 1.f / (1.f + __expf(-bf1(gl[8 + hd])));
        const f32x4 oc = *((const f32x4*)((const float*)(a.ws + WS_OCMP) + (size_t)tok * 256) + lane), os = *((const f32x4*)((const float*)(a.ws + WS_OSLC) + (size_t)tok * 256) + lane),
                    ow = *((const f32x4*)((const float*)(a.ws + WS_OWIN) + (size_t)tok * 256) + lane);
        const f32x4 v = oc * g0 + os * g1 + ow * g2;
        float rstd = rsqrtf(wave_sum((v.x * v.x + v.y * v.y) + (v.z * v.z + v.w * v.w)) * (1.f / 256.f) + RMS_EPS);
        f32x4 gv = *((const f32x4*)gg + lane);
        v2u w; w.x = pk2(v.x * rstd * gv.x, v.y * rstd * gv.y); w.y = pk2(v.z * rstd * gv.z, v.w * rstd * gv.w);
        *((v2u*)(MIX + (size_t)tok * DM) + lane) = w;
        const f32x4 s0 = *((const f32x4*)((const float*)(a.ws + WS_OSWA) + (size_t)tok * 512) + 2 * lane), s1 = *((const f32x4*)((const float*)(a.ws + WS_OSWA) + (size_t)tok * 512) + 2 * lane + 1);
        rstd = rsqrtf(wave_sum(((s0.x * s0.x + s0.y * s0.y) + (s0.z * s0.z + s0.w * s0.w)) + ((s1.x * s1.x + s1.y * s1.y) + (s1.z * s1.z + s1.w * s1.w))) * (1.f / 512.f) + RMS_EPS);
        const f32x4 ga = *((const f32x4*)(gg + 256) + 2 * lane), gb = *((const f32x4*)(gg + 256) + 2 * lane + 1);
        v4u w4; w4.x = pk2(s0.x * rstd * ga.x, s0.y * rstd * ga.y); w4.y = pk2(s0.z * rstd * ga.z, s0.w * rstd * ga.w); w4.z = pk2(s1.x * rstd * gb.x, s1.y * rstd * gb.y); w4.w = pk2(s1.z * rstd * gb.z, s1.w * rstd * gb.w);
        *((v4u*)(MIX + (size_t)tok * DM + 256) + lane) = w4;
        const f32x4 sb = *((const f32x4*)((const float*)(a.ws + WS_OSB) + (size_t)tok * 256) + lane);
        rstd = rsqrtf(wave_sum((sb.x * sb.x + sb.y * sb.y) + (sb.z * sb.z + sb.w * sb.w)) * (1.f / 256.f) + RMS_EPS);
        gv = *((const f32x4*)(gg + 768) + lane);
        w.x = pk2(sb.x * rstd * gv.x, sb.y * rstd * gv.y); w.y = pk2(sb.z * rstd * gv.z, sb.w * rstd * gv.w);
        *((v2u*)(MIX + (size_t)tok * DM + 768) + lane) = w;
    }
}
__device__ __forceinline__ void p_postnorm(const Args& a, const float* xold, const float* gpost, const float* gnext, int lane, int wave) {
    const bf16* F = (const bf16*)(a.ws + WS_F); bf16* XN = (bf16*)(a.ws + WS_XN);
    const int gw = blockIdx.x * NWAVES + wave, NGW = gridDim.x * NWAVES;
    for (int tok = gw; tok < M; tok += NGW) {
        f32x4 f[4]; float s = 0.f;
#pragma unroll
        for (int j = 0; j < 4; ++j) { const v2u w = *((const v2u*)(F + (size_t)tok * DM) + lane + 64 * j); f[j] = (f32x4){bf_lo(w.x), bf_hi(w.x), bf_lo(w.y), bf_hi(w.y)};
            s += (f[j].x * f[j].x + f[j].y * f[j].y) + (f[j].z * f[j].z + f[j].w * f[j].w); }
        const float rstd = rsqrtf(wave_sum(s) * (1.f / DM) + RMS_EPS);
        float s2 = 0.f;
#pragma unroll
        for (int j = 0; j < 4; ++j) { const f32x4 xo = *((const f32x4*)(xold + (size_t)tok * DM) + lane + 64 * j); const f32x4 gp = *((const f32x4*)gpost + lane + 64 * j);
            f[j] = xo + f[j] * rstd * gp; *((f32x4*)(a.out + (size_t)tok * DM) + lane + 64 * j) = f[j];
            s2 += (f[j].x * f[j].x + f[j].y * f[j].y) + (f[j].z * f[j].z + f[j].w * f[j].w); }
        if (gnext) { const float r2 = rsqrtf(wave_sum(s2) * (1.f / DM) + RMS_EPS);
#pragma unroll
            for (int j = 0; j < 4; ++j) { const f32x4 gn = *((const f32x4*)gnext + lane + 64 * j); v2u w; w.x = pk2(f[j].x * r2 * gn.x, f[j].y * r2 * gn.y); w.y = pk2(f[j].z * r2 * gn.z, f[j].w * r2 * gn.w);
                *((v2u*)(XN + (size_t)tok * DM) + lane + 64 * j) = w; } }
    }
}

__global__ void __launch_bounds__(NWAVES * 64, 2) hyb_fwd(Args args) {
    extern __shared__ __attribute__((aligned(16))) unsigned char lds_raw[];
    LAS unsigned char* lds = (LAS unsigned char*)lds_raw;
    const int tid = threadIdx.x, lane = tid & 63, wave = __builtin_amdgcn_readfirstlane(tid >> 6);
    const int G = gridDim.x;
    for (int u = tid; u < (LDS_BYTES - LDSCTL_OFF) / 4; u += NWAVES * 64) ((LAS unsigned*)(lds + LDSCTL_OFF))[u] = 0u;
    __syncthreads();
    unsigned* ctl = (unsigned*)(args.ws + WS_CTL);
    XcdBarrier bar = xcd_barrier_post(ctl + CW_BAR + args.li * XCD_BAR_WORDS, (volatile LAS unsigned*)(lds + MISC_OFF) + 8);
    const int lo = args.ph_lo, hi = args.ph_hi;
#define IN(k) (lo <= (k) && (k) < hi)
#define LAUNDER int tid_ = tid; asm volatile("" : "+v"(tid_)); const int lane_ = tid_ & 63, wave_ = __builtin_amdgcn_readfirstlane(tid_ >> 6)
#define SEAM(k) do { if ((k) + 1 < hi) xcd_barrier(bar); else { VM_WAIT(); __syncthreads(); } } while (0)
    unsigned char* ws = args.ws;
    if ((PHMASK & 1) && IN(0)) { LAUNDER; p0_prologue(args, lds, tid_, lane_, wave_); SEAM(0); }
    for (int l = 0; l < DEPTH; ++l) {
        const int pb = 1 + 11 * l;
        if (((PHMASK >> 1) & 1) && IN(pb + 0)) {
            pg8::Gemm g{(const pg8::bf16_t*)(ws + WS_XN), (const pg8::bf16_t*)(ws + WS_WIN) + (size_t)l * INP * DM, M, INP, DM, (size_t)DM * 2, 128};
            pg8::StaticOrder S; S.init(M, INP, G, (int)blockIdx.x);
            pg8::EpiBf16<0> E{(pg8::bf16_t*)(ws + WS_PROJ), INP, nullptr};
            pg8::gemm_phase<pg8::EpiBf16<0>, pg8::StaticOrder, true, true>(lds + RING_OFF, g, S, E);
            SEAM(pb + 0);
        }
        if (((PHMASK >> 2) & 1) && IN(pb + 1)) {
            pg8::StaticOrder S; S.init(2 * NCP, 256, G, (int)blockIdx.x);
            { pg8::Gemm g{(const pg8::bf16_t*)(ws + WS_PROJ) + C_KC, (const pg8::bf16_t*)(ws + WS_W1) + (size_t)(l * 2 + 0) * 256 * 2048, 2 * NCP, 256, 2048, (size_t)16 * INP * 2, (size_t)INP * 2};
              pg8::EpiBf16<2> E{(pg8::bf16_t*)(ws + WS_HIDC), 256, (const float*)(ws + WS_POSB) + (l * 2 + 0) * 256};
              pg8::gemm_phase<pg8::EpiBf16<2>, pg8::StaticOrder, true, true>(lds + RING_OFF, g, S, E); }
            pg8::StaticOrder S2; S2.init(2 * NCP, 256, G, (int)((blockIdx.x + G / 2) % G));
            { pg8::Gemm g{(const pg8::bf16_t*)(ws + WS_PROJ) + C_VC, (const pg8::bf16_t*)(ws + WS_W1) + (size_t)(l * 2 + 1) * 256 * 2048, 2 * NCP, 256, 2048, (size_t)16 * INP * 2, (size_t)INP * 2};
              pg8::EpiBf16<2> E{(pg8::bf16_t*)(ws + WS_HIDC) + (size_t)2 * NCP * 256, 256, (const float*)(ws + WS_POSB) + (l * 2 + 1) * 256};
              pg8::gemm_phase<pg8::EpiBf16<2>, pg8::StaticOrder, true, true>(lds + RING_OFF, g, S2, E); }
            SEAM(pb + 1);
        }
        if (((PHMASK >> 3) & 1) && IN(pb + 2)) { LAUNDER; p_compress2(args, l, tid_); SEAM(pb + 2); }
        if (((PHMASK >> 4) & 1) && IN(pb + 3)) { LAUNDER; p_attn_a(args, l, lds, tid_, lane_, wave_); SEAM(pb + 3); }
        if (((PHMASK >> 5) & 1) && IN(pb + 4)) { LAUNDER; p_attn_b(args, lds, tid_, lane_, wave_); SEAM(pb + 4); }
        if (((PHMASK >> 6) & 1) && IN(pb + 5)) { LAUNDER; p_groupnorm(args, l, lane_, wave_); SEAM(pb + 5); }
        if (((PHMASK >> 7) & 1) && IN(pb + 6)) {
            pg8::Gemm g{(const pg8::bf16_t*)(ws + WS_XN), (const pg8::bf16_t*)(ws + WS_WOUT) + (size_t)l * DM * DM, M, DM, DM, (size_t)DM * 2, 128};
            pg8::StaticOrder S; S.init(M, DM, G, (int)blockIdx.x);
            pg8::EpiBf16<0> E{(pg8::bf16_t*)(ws + WS_F), DM, nullptr};
            pg8::gemm_phase<pg8::EpiBf16<0>, pg8::StaticOrder, true, true>(lds + RING_OFF, g, S, E);
            SEAM(pb + 6);
        }
        if (((PHMASK >> 8) & 1) && IN(pb + 7)) {
            LAUNDER; p_postnorm(args, l == 0 ? args.in[I_X] : args.out, args.in[I_LNAPOST] + (size_t)l * DM, args.in[I_LNFP] + (size_t)l * DM, lane_, wave_); SEAM(pb + 7);
        }
        if (((PHMASK >> 9) & 1) && IN(pb + 8)) {
            pg8::Gemm g{(const pg8::bf16_t*)(ws + WS_XN), (const pg8::bf16_t*)(ws + WS_WGU) + (size_t)l * NGU * DM, M, NGU, DM, (size_t)DM * 2, 128};
            pg8::StaticOrder S; S.init(M, NGU, G, (int)blockIdx.x);
            pg8::EpiSwiGLU E{(pg8::bf16_t*)(ws + WS_HID), DFF};
            pg8::gemm_phase<pg8::EpiSwiGLU, pg8::StaticOrder, true, true>(lds + RING_OFF, g, S, E);
            SEAM(pb + 8);
        }
        if (((PHMASK >> 10) & 1) && IN(pb + 9)) {
            pg8::Gemm g{(const pg8::bf16_t*)(ws + WS_HID), (const pg8::bf16_t*)(ws + WS_WDN) + (size_t)l * DM * DFF, M, DM, DFF, (size_t)DFF * 2, 128};
            pg8::StaticOrder S; S.init(M, DM, G, (int)blockIdx.x);
            pg8::EpiBf16<0> E{(pg8::bf16_t*)(ws + WS_F), DM, nullptr};
            pg8::gemm_phase<pg8::EpiBf16<0>, pg8::StaticOrder, true, true>(lds + RING_OFF, g, S, E);
            SEAM(pb + 9);
        }
        if (((PHMASK >> 11) & 1) && IN(pb + 10)) {
            LAUNDER; p_postnorm(args, args.out, args.in[I_LNFPOST] + (size_t)l * DM, l + 1 < DEPTH ? args.in[I_LNAP] + (size_t)(l + 1) * DM : nullptr, lane_, wave_); SEAM(pb + 10);
        }
    }
#undef IN
#undef SEAM
}

#ifndef PHMASK
#define PHMASK 0xFFF
#endif
#ifndef MK_ONE_LAUNCH
#define MK_ONE_LAUNCH 0
#endif
extern "C" void kernel_launch(void* const* d_in, const int* in_sizes, int n_in, void* d_out, int out_size, void* d_ws, size_t ws_size, hipStream_t stream) {
    static int grid = 0;
    if (grid == 0) {
        if (n_in != 17 || in_sizes[0] != M * DM || out_size != M * DM || ws_size < WS_END) { fprintf(stderr, "kernel_launch: unexpected shapes (n_in %d, in0 %d, out %d, ws %zu); nothing launched\n", n_in, n_in > 0 ? in_sizes[0] : -1, out_size, ws_size); grid = -1; return; }
        int dev = 0, cus = 0, per_cu = 0;
        if (hipGetDevice(&dev) != hipSuccess || hipDeviceGetAttribute(&cus, hipDeviceAttributeMultiprocessorCount, dev) != hipSuccess) { grid = -1; return; }
        if (hipFuncSetAttribute((const void*)hyb_fwd, hipFuncAttributeMaxDynamicSharedMemorySize, LDS_BYTES) != hipSuccess) { fprintf(stderr, "kernel_launch: hipFuncSetAttribute failed\n"); grid = -1; return; }
        if (hipOccupancyMaxActiveBlocksPerMultiprocessor(&per_cu, (const void*)hyb_fwd, NWAVES * 64, LDS_BYTES) != hipSuccess || per_cu < 1) fprintf(stderr, "kernel_launch: occupancy query reports %d workgroups per CU\n", per_cu);
        (void)hipGetLastError();
        grid = cus;
    }
    if (grid < 0) return;
    if (hipMemsetAsync((char*)d_ws + WS_CTL, 0, CTL_ZERO_BYTES, stream) != hipSuccess) return;
    Args a{};
    for (int i = 0; i < 17; ++i) a.in[i] = (const float*)d_in[i];
    a.out = (float*)d_out; a.ws = (unsigned char*)d_ws;
#if MK_ONE_LAUNCH
    a.ph_lo = 0; a.ph_hi = NPH; a.li = 0;
    hipLaunchKernelGGL(hyb_fwd, dim3(grid), dim3(NWAVES * 64), LDS_BYTES, stream, a);
#else
    for (int p = 0; p < NPH; ++p) { a.ph_lo = p; a.ph_hi = p + 1; a.li = p;
        hipLaunchKernelGGL(hyb_fwd, dim3(grid), dim3(NWAVES * 64), LDS_BYTES, stream, a); }
#endif
}
```

```cpp
#include <hip/hip_runtime.h>
#include <cstdio>
#include <cstdint>
#ifndef PHMASK
#define PHMASK 0xFFF
#endif
namespace pg8 {
#define PG8_LAS __attribute__((address_space(3)))
typedef unsigned short bf16_t;
typedef short bf16x8 __attribute__((ext_vector_type(8)));
typedef float f32x4 __attribute__((ext_vector_type(4)));
typedef unsigned u32x4 __attribute__((ext_vector_type(4)));
constexpr int BM = 256, BK = 64, HALF = 128, HTB = HALF * BK * 2  , STAGE_BYTES = 8 * HTB, NXCD = 8, WGM = 8;

__host__ __device__ __forceinline__ int lds_byte(int r, int c) { const int st = (r >> 4) * 2 + (c >> 5), rr = r & 15, cc = c & 31, ob = rr * 64 + cc * 2; return st * 1024 + (ob ^ (((ob >> 9) & 1) << 5)); }
__host__ __device__ __forceinline__ void stage_rc(int b, int& R, int& C) { const int st = b / 1024, sb = b % 1024, swz = sb ^ (((sb >> 9) & 1) << 5); R = (st >> 1) * 16 + swz / 64; C = (st & 1) * 32 + (swz % 64) / 2; }
__host__ __device__ __forceinline__ int perm32(int rho) { const int n = rho >> 4, i = rho & 15; return 8 * (i >> 2) + 4 * n + (i & 3); }

struct Unit { int pm, pn; };
struct Gemm { const bf16_t* A; const bf16_t* Bt; int M, N, K; size_t a_row_bytes, a_kstep_bytes; };

struct StaticOrder {
    int nM, nN, nwg, G, c;
    __host__ __device__ void init(int M, int N, int G_, int c_) { nM = M / BM; nN = N / BM; nwg = nM * nN; G = G_; c = c_; }
    __host__ __device__ bool next(int i, Unit& u) const {
        const long L = (long)i * G + c; if (L >= nwg) return false;
        int wgid = (int)L; { const int q = nwg / NXCD, r = nwg % NXCD, xcd = wgid % NXCD, off = wgid / NXCD; wgid = (xcd < r ? xcd * (q + 1) : r * (q + 1) + (xcd - r) * q) + off; }
        const int nig = WGM * nN, gid = wgid / nig, fm = gid * WGM, gsz = (nM - fm) < WGM ? (nM - fm) : WGM;
        u.pm = fm + ((wgid % nig) % gsz); u.pn = (wgid % nig) / gsz; return true;
    }
    __device__ __forceinline__ void a_ready(const Unit&) const {}
    __device__ __forceinline__ void done(const Unit&) const {}
};

__device__ __forceinline__ unsigned cvt_pk_bf16(float lo, float hi) { unsigned r; asm volatile("v_cvt_pk_bf16_f32 %0, %1, %2" : "=v"(r) : "v"(lo), "v"(hi)); return r; }
typedef float f32x2 __attribute__((ext_vector_type(2)));
__device__ __forceinline__ float silu_f(float x) { return x * __builtin_amdgcn_rcpf(1.0f + __expf(-x)); }
template <int ACT  > struct EpiBf16 {
    static constexpr bool PERM = true, AFTER_DRAIN = false;
    bf16_t* O; int ldc; const float* bias;
    __device__ __forceinline__ void operator()(const f32x4 (&acc)[2][2][4][2], const Unit& u, int wr, int wc, int fr, int fq) const {
        const int row0 = u.pm * BM + wr * 64 + fr; const int col0 = u.pn * BM + wc * 32 + 8 * fq;
        f32x4 bv[2][2];
#pragma unroll
        for (int bj = 0; bj < 2; ++bj)
#pragma unroll
            for (int n = 0; n < 2; ++n) bv[bj][n] = bias ? *(const f32x4*)(bias + col0 + bj * HALF + 4 * n) : (f32x4){0.f, 0.f, 0.f, 0.f};
#pragma unroll
        for (int ai = 0; ai < 2; ++ai)
#pragma unroll
            for (int m = 0; m < 4; ++m) { bf16_t* rowp = O + (size_t)(row0 + ai * HALF + m * 16) * ldc + col0;
#pragma unroll
                for (int bj = 0; bj < 2; ++bj) { f32x4 v0 = acc[ai][bj][m][0] + bv[bj][0], v1 = acc[ai][bj][m][1] + bv[bj][1];
                    if (ACT == 2) { v0 = (f32x4){silu_f(v0[0]), silu_f(v0[1]), silu_f(v0[2]), silu_f(v0[3])}; v1 = (f32x4){silu_f(v1[0]), silu_f(v1[1]), silu_f(v1[2]), silu_f(v1[3])}; }
                    u32x4 w; w.x = cvt_pk_bf16(v0[0], v0[1]); w.y = cvt_pk_bf16(v0[2], v0[3]); w.z = cvt_pk_bf16(v1[0], v1[1]); w.w = cvt_pk_bf16(v1[2], v1[3]);
                    *(u32x4*)(rowp + bj * HALF) = w; } }
    }
};
struct EpiSwiGLU {
    static constexpr bool PERM = true, AFTER_DRAIN = false;
    bf16_t* O; int ldc;
    __device__ __forceinline__ void operator()(const f32x4 (&acc)[2][2][4][2], const Unit& u, int wr, int wc, int fr, int fq) const {
        const int row0 = u.pm * BM + wr * 64 + fr; const int col0 = u.pn * HALF + wc * 32 + 8 * fq;
#pragma unroll
        for (int ai = 0; ai < 2; ++ai)
#pragma unroll
            for (int m = 0; m < 4; ++m) { bf16_t* rowp = O + (size_t)(row0 + ai * HALF + m * 16) * ldc + col0;
                const f32x4 g0 = acc[ai][0][m][0], g1 = acc[ai][0][m][1], u0 = acc[ai][1][m][0], u1 = acc[ai][1][m][1];
                u32x4 w; w.x = cvt_pk_bf16(silu_f(g0[0]) * u0[0], silu_f(g0[1]) * u0[1]); w.y = cvt_pk_bf16(silu_f(g0[2]) * u0[2], silu_f(g0[3]) * u0[3]);
                w.z = cvt_pk_bf16(silu_f(g1[0]) * u1[0], silu_f(g1[1]) * u1[1]); w.w = cvt_pk_bf16(silu_f(g1[2]) * u1[2], silu_f(g1[3]) * u1[3]);
                *(u32x4*)rowp = w; }
    }
};
template <class Epi, class Sched, bool ALIGN_EPI = false, bool SP2 = false>
__device__ __forceinline__ void gemm_phase(PG8_LAS unsigned char* lds, const Gemm g, const Sched& S, const Epi& E) {
    int tid_l = threadIdx.x; asm volatile("" : "+v"(tid_l));
    const int tid = tid_l, wid = __builtin_amdgcn_readfirstlane(tid >> 6), lane = tid & 63, wr = wid >> 2, wc = wid & 3, fr = lane & 15, fq = lane >> 4;
    const int K = g.K, nt = K / BK;
    unsigned voffA[2], voffB[2];
#pragma unroll
    for (int i = 0; i < 2; ++i) { int R, C; stage_rc(tid * 16 + i * 8192, R, C); const int Rb = Epi::PERM ? ((R & ~31) + perm32(R & 31)) : R;
        voffA[i] = (unsigned)((size_t)R * g.a_row_bytes + (size_t)C * 2u); voffB[i] = (unsigned)(Rb * K + C) * 2u; }
    const size_t kstepB = (size_t)(BK * 2), kstepA = g.a_kstep_bytes;
    const size_t hstepB = (size_t)HALF * K * 2, hstepA = (size_t)HALF * g.a_row_bytes;
    const size_t tstepB = 2 * hstepB, tstepA = 2 * hstepA;
    const unsigned ldsw = (unsigned)wid * 1024u;
    const int aoff = lds_byte(wr * 64 + fr, fq * 8), boff = lds_byte(wc * 32 + fr, fq * 8);
#define PG8_SA(b, h) (((b) * 2 + (h)) * HTB)
#define PG8_SB(b, h) ((4 + (b) * 2 + (h)) * HTB)
#define PG8_STAGE(bufoff, gbase, voff) do { _Pragma("unroll") for (int _i = 0; _i < 2; ++_i) \
        __builtin_amdgcn_global_load_lds((const unsigned*)((const char*)(gbase) + (voff)[_i]), (PG8_LAS unsigned*)(lds + (bufoff) + ldsw + _i * 8192), 16, 0, 0); } while (0)
#define PG8_LDA(dst, b, h) do { _Pragma("unroll") for (int m = 0; m < 4; ++m) _Pragma("unroll") for (int k = 0; k < 2; ++k) dst[m][k] = *(const PG8_LAS bf16x8*)(lds + PG8_SA(b, h) + aoff + m * 2048 + k * 1024); } while (0)
#define PG8_LDB(dst, b, h) do { _Pragma("unroll") for (int n = 0; n < 2; ++n) _Pragma("unroll") for (int k = 0; k < 2; ++k) dst[n][k] = *(const PG8_LAS bf16x8*)(lds + PG8_SB(b, h) + boff + n * 2048 + k * 1024); } while (0)
#define PG8_MMA(ai, bj, At, Bt) do { __builtin_amdgcn_s_setprio(1); _Pragma("unroll") for (int m = 0; m < 4; ++m) _Pragma("unroll") for (int n = 0; n < 2; ++n) _Pragma("unroll") for (int k = 0; k < 2; ++k) \
        acc[ai][bj][m][n] = __builtin_amdgcn_mfma_f32_16x16x32_bf16(Bt[n][k], At[m][k], acc[ai][bj][m][n], 0, 0, 0); __builtin_amdgcn_s_setprio(0); } while (0)
#define PG8_WAIT_V(n) asm volatile("s_waitcnt vmcnt(" #n ")" ::: "memory")
#define PG8_WAIT_L(n) asm volatile("s_waitcnt lgkmcnt(" #n ")" ::: "memory")
#define PG8_BAR __builtin_amdgcn_s_barrier()
#define PG8_SCHED __builtin_amdgcn_sched_barrier(0)
    Unit cur, nxt; int ui = 0;
    if (!S.next(0, cur)) return;
    f32x4 acc[2][2][4][2];
#pragma unroll
    for (int a = 0; a < 2; ++a)
#pragma unroll
        for (int b = 0; b < 2; ++b)
#pragma unroll
            for (int m = 0; m < 4; ++m)
#pragma unroll
                for (int n = 0; n < 2; ++n) acc[a][b][m][n] = (f32x4){0.f, 0.f, 0.f, 0.f};
    bf16x8 At[4][2], B0[2][2], B1[2][2];
    const char* cA = (const char*)g.A + (size_t)cur.pm * tstepA; const char* cB = (const char*)g.Bt + (size_t)cur.pn * tstepB;
    S.a_ready(cur);
    if constexpr (SP2) {
        PG8_STAGE(PG8_SB(0, 0), cB, voffB); PG8_STAGE(PG8_SB(0, 1), cB + hstepB, voffB); PG8_STAGE(PG8_SA(0, 0), cA, voffA); PG8_STAGE(PG8_SA(0, 1), cA + hstepA, voffA);
        if (wr == 1) PG8_BAR;
        PG8_WAIT_V(2); PG8_BAR;
        PG8_STAGE(PG8_SB(1, 0), cB + kstepB, voffB); PG8_STAGE(PG8_SA(1, 0), cA + kstepA, voffA); PG8_STAGE(PG8_SB(1, 1), cB + hstepB + kstepB, voffB);
        PG8_WAIT_V(6); PG8_BAR;
    } else {
        PG8_STAGE(PG8_SB(0, 0), cB, voffB); PG8_STAGE(PG8_SA(0, 0), cA, voffA); PG8_STAGE(PG8_SB(0, 1), cB + hstepB, voffB); PG8_STAGE(PG8_SA(0, 1), cA + hstepA, voffA);
        if (wr == 1) PG8_BAR;
        PG8_WAIT_V(4); PG8_BAR;
        PG8_STAGE(PG8_SB(1, 0), cB + kstepB, voffB); PG8_STAGE(PG8_SA(1, 0), cA + kstepA, voffA); PG8_STAGE(PG8_SB(1, 1), cB + hstepB + kstepB, voffB);
        PG8_WAIT_V(6); PG8_BAR;
    }
    for (;;) {
        const bool has_next = S.next(ui + 1, nxt);
        const char* nA = has_next ? (const char*)g.A + (size_t)nxt.pm * tstepA : cA; const char* nB = has_next ? (const char*)g.Bt + (size_t)nxt.pn * tstepB : cB;
        for (int t = 0; t < nt; t += 2) {
            const bool last = (t == nt - 2);
            const char* a1 = cA + (size_t)(t + 1) * kstepA;
            const char* a2 = last ? nA : cA + (size_t)(t + 2) * kstepA; const char* b2 = last ? nB : cB + (size_t)(t + 2) * kstepB;
            const char* a3 = a2 + kstepA; const char* b3 = b2 + kstepB;
            if (last && has_next) S.a_ready(nxt);
            if constexpr (SP2) {
            PG8_LDB(B0, 0, 0); PG8_LDB(B1, 0, 1); PG8_SCHED; PG8_LDA(At, 0, 0); PG8_STAGE(PG8_SA(1, 1), a1 + hstepA, voffA);
            PG8_WAIT_V(8); PG8_WAIT_L(0); PG8_BAR; PG8_MMA(0, 0, At, B0); PG8_MMA(0, 1, At, B1); PG8_BAR; PG8_SCHED;
            PG8_LDA(At, 0, 1); PG8_STAGE(PG8_SB(0, 0), b2, voffB); PG8_STAGE(PG8_SB(0, 1), b2 + hstepB, voffB); PG8_STAGE(PG8_SA(0, 0), a2, voffA);
            PG8_WAIT_V(8); PG8_WAIT_L(0); PG8_BAR; PG8_MMA(1, 0, At, B0); PG8_MMA(1, 1, At, B1); PG8_BAR; PG8_SCHED;
            PG8_LDB(B0, 1, 0); PG8_LDB(B1, 1, 1); PG8_SCHED; PG8_LDA(At, 1, 0); PG8_STAGE(PG8_SA(0, 1), a2 + hstepA, voffA);
            PG8_WAIT_V(8); PG8_WAIT_L(0); PG8_BAR; PG8_MMA(0, 0, At, B0); PG8_MMA(0, 1, At, B1); PG8_BAR; PG8_SCHED;
            PG8_LDA(At, 1, 1); PG8_STAGE(PG8_SB(1, 0), b3, voffB); PG8_STAGE(PG8_SB(1, 1), b3 + hstepB, voffB); PG8_STAGE(PG8_SA(1, 0), a3, voffA);
            PG8_WAIT_V(8); PG8_WAIT_L(0); PG8_BAR; PG8_MMA(1, 0, At, B0); PG8_MMA(1, 1, At, B1); PG8_BAR; PG8_SCHED;
            } else {
            PG8_LDB(B0, 0, 0); PG8_SCHED; PG8_LDA(At, 0, 0); PG8_STAGE(PG8_SA(1, 1), a1 + hstepA, voffA);
            PG8_WAIT_L(8); PG8_BAR; PG8_WAIT_L(0); PG8_MMA(0, 0, At, B0); PG8_BAR; PG8_SCHED;
            PG8_LDB(B1, 0, 1); PG8_STAGE(PG8_SB(0, 0), b2, voffB);
            PG8_BAR; PG8_WAIT_L(0); PG8_MMA(0, 1, At, B1); PG8_BAR;
            PG8_LDA(At, 0, 1); PG8_STAGE(PG8_SA(0, 0), a2, voffA);
            PG8_BAR; PG8_WAIT_L(0); PG8_MMA(1, 0, At, B0); PG8_BAR; PG8_SCHED;
            PG8_STAGE(PG8_SB(0, 1), b2 + hstepB, voffB);
            PG8_WAIT_V(6); PG8_BAR; PG8_MMA(1, 1, At, B1); PG8_BAR;
            PG8_LDB(B0, 1, 0); PG8_SCHED; PG8_LDA(At, 1, 0); PG8_STAGE(PG8_SA(0, 1), a2 + hstepA, voffA);
            PG8_WAIT_L(8); PG8_BAR; PG8_WAIT_L(0); PG8_MMA(0, 0, At, B0); PG8_BAR; PG8_SCHED;
            PG8_LDB(B1, 1, 1); PG8_STAGE(PG8_SB(1, 0), b3, voffB);
            PG8_BAR; PG8_WAIT_L(0); PG8_MMA(0, 1, At, B1); PG8_BAR;
            PG8_LDA(At, 1, 1); PG8_STAGE(PG8_SA(1, 0), a3, voffA);
            PG8_BAR; PG8_WAIT_L(0); PG8_MMA(1, 0, At, B0); PG8_BAR; PG8_SCHED;
            PG8_STAGE(PG8_SB(1, 1), b3 + hstepB, voffB);
            PG8_WAIT_V(6); PG8_BAR; PG8_MMA(1, 1, At, B1); PG8_BAR;
            }
        }
        if constexpr (ALIGN_EPI) { if (wr == 0) PG8_BAR; }
        if constexpr (!Epi::AFTER_DRAIN) { E(acc, cur, wr, wc, fr, fq); S.done(cur); }
        if (!has_next) break;
#pragma unroll
        for (int a = 0; a < 2; ++a)
#pragma unroll
            for (int b = 0; b < 2; ++b)
#pragma unroll
                for (int m = 0; m < 4; ++m)
#pragma unroll
                    for (int n = 0; n < 2; ++n) acc[a][b][m][n] = (f32x4){0.f, 0.f, 0.f, 0.f};
        cur = nxt; cA = nA; cB = nB; ++ui;
        if constexpr (ALIGN_EPI) { if (wr == 1) PG8_BAR; }
    }
    PG8_WAIT_V(0);
    if constexpr (!ALIGN_EPI) { if (wr == 0) PG8_BAR; }
    PG8_BAR;
    if constexpr (Epi::AFTER_DRAIN) { E.fused(acc, cur, wr, wc, fr, fq, lds, wid, lane); S.done(cur); }
#undef PG8_SA
#undef PG8_SB
#undef PG8_STAGE
#undef PG8_LDA
#undef PG8_LDB
#undef PG8_MMA
#undef PG8_WAIT_V
#undef PG8_WAIT_L
#undef PG8_BAR
#undef PG8_SCHED
}
}
constexpr int NWAVES = 8;
constexpr int BATCH = 2, SEQ = 16384, DM = 1024, DEPTH = 2, M = BATCH * SEQ, HD = 64;
constexpr int INW = 2188, INP = 2304, DFF = 2816, NGU = 2 * DFF;
constexpr int C_NQ = 0, C_KC = 256, C_VC = 320, C_KS = 384, C_VS = 448, C_KW = 512, C_VW = 576, C_SQ = 640, C_SK = 1152, C_SV = 1280, C_BQ = 1408, C_BK = 1664, C_BV = 1920, C_NG = 2176;
constexpr int NCP = 1024;
constexpr float RMS_EPS = 1e-6f;
constexpr int NPH = 1 + 11 * DEPTH;

constexpr size_t MiB = 1u << 20;
constexpr size_t WS_CTL = 0, CTL_ZERO_BYTES = 1 * MiB;
constexpr size_t WS_WIN = 2 * MiB, WS_WOUT = 11 * MiB, WS_WGU = 15 * MiB, WS_WDN = 37 * MiB, WS_W1 = 48 * MiB, WS_POSB = 52 * MiB, WS_KVC = 53 * MiB, WS_HIDC = 54 * MiB;
constexpr size_t WS_XN = 64 * MiB, WS_PROJ = 128 * MiB, WS_HID = 128 * MiB, WS_IMP = 272 * MiB;
constexpr size_t WS_OCMP = 304 * MiB, WS_OSLC = 336 * MiB, WS_OWIN = 368 * MiB, WS_OSWA = 400 * MiB, WS_OSB = 464 * MiB, WS_F = 304 * MiB, WS_END = 496 * MiB;
static_assert(WS_WIN + (size_t)DEPTH * INP * DM * 2 <= WS_WOUT && WS_WOUT + (size_t)DEPTH * DM * DM * 2 <= WS_WGU && WS_WGU + (size_t)DEPTH * NGU * DM * 2 <= WS_WDN && WS_WDN + (size_t)DEPTH * DM * DFF * 2 <= WS_W1 && WS_W1 + (size_t)DEPTH * 2 * 256 * 2048 * 2 <= WS_POSB, "weights map");
static_assert(WS_PROJ + (size_t)M * INP * 2 <= WS_IMP && WS_HID + (size_t)M * DFF * 2 <= WS_OCMP && WS_IMP + (size_t)M * 256 * 4 <= WS_OCMP && WS_OSB + (size_t)M * 256 * 4 <= WS_END, "activation map");
constexpr int CW_BAR = 4096;

constexpr int RING_OFF = 0, RING_BYTES = 131072;
constexpr int LDSCTL_OFF = RING_BYTES, MISC_OFF = LDSCTL_OFF + 320;
constexpr int LDS_BYTES = 147456;

#define GAS __attribute__((address_space(1)))
#define LAS __attribute__((address_space(3)))
typedef unsigned short bf16;
typedef unsigned v4u __attribute__((ext_vector_type(4)));
typedef unsigned v2u __attribute__((ext_vector_type(2)));
typedef float f32x4 __attribute__((ext_vector_type(4)));
typedef GAS unsigned gu32;
#define LDS_WAIT() asm volatile("s_waitcnt lgkmcnt(0)" ::: "memory")
#define VM_WAIT() asm volatile("s_waitcnt vmcnt(0)" ::: "memory")
__device__ __forceinline__ unsigned f2bf(float f) { unsigned u = __builtin_bit_cast(unsigned, f); return (u + 0x7fffu + ((u >> 16) & 1u)) >> 16; }
__device__ __forceinline__ unsigned pk2(float lo, float hi) { return f2bf(lo) | (f2bf(hi) << 16); }
__device__ __forceinline__ float bf_lo(unsigned u) { return __uint_as_float(u << 16); }
__device__ __forceinline__ float bf_hi(unsigned u) { return __uint_as_float(u & 0xffff0000u); }
__device__ __forceinline__ float bf1(bf16 b) { return __uint_as_float(((unsigned)b) << 16); }

#define XB_TMO      128
#define XB_XCNT(j)  (256  + 64 * (j))
#define XB_XSUB(j)  (1280 + 64 * (j))
#define XB_XGEN(j)  (2304 + 64 * (j))
#define XB_TOP      3328
#define XB_TOPGEN   3392
#define XCD_BAR_WORDS 3456
#define XB_SPIN_CAP (1u << 18)
__device__ __forceinline__ unsigned xb_ld(unsigned* p)              { return __hip_atomic_load(p, __ATOMIC_RELAXED, __HIP_MEMORY_SCOPE_AGENT); }
__device__ __forceinline__ unsigned xb_add(unsigned* p, unsigned v) { return __hip_atomic_fetch_add(p, v, __ATOMIC_RELAXED, __HIP_MEMORY_SCOPE_AGENT); }
__device__ __forceinline__ unsigned xb_xcc_id() { return (unsigned)__builtin_amdgcn_s_getreg((3 << 11) | 20) & 0xFu; }
#define XB_SPIN(cond, bar) do { unsigned _sp = 0; while (cond) { __builtin_amdgcn_s_sleep(1); \
    if ((++_sp & 255u) == 0u) { if (xb_ld(&(bar)[XB_TMO])) break; if (_sp > XB_SPIN_CAP) { atomicAdd(&(bar)[XB_TMO], 1u); break; } } } } while (0)
struct XcdBarrier { unsigned* bar; unsigned x; volatile LAS unsigned* st; };
__device__ __forceinline__ XcdBarrier xcd_barrier_post(unsigned* bar, volatile LAS unsigned* st) {
    XcdBarrier b; b.bar = bar; b.x = xb_xcc_id(); b.st = st;
    if (threadIdx.x == 0) (void)xb_add(&bar[XB_XCNT(b.x)], 1u);
    return b;
}
__device__ __forceinline__ void xcd_barrier_complete(unsigned* bar, unsigned x, unsigned& nloc, unsigned& nx) {
    const unsigned G = gridDim.x * gridDim.y * gridDim.z;
    unsigned sum, cnt, mine, sp = 0u;
    for (;;) {
        sum = 0u; cnt = 0u; mine = 0u;
#pragma unroll
        for (unsigned j = 0; j < 16; ++j) { const unsigned c = xb_ld(&bar[XB_XCNT(j)]); sum += c; cnt += (c > 0u) ? 1u : 0u; mine = (j == x) ? c : mine; }
        if (sum == G) break;
        __builtin_amdgcn_s_sleep(1);
        if ((++sp & 255u) == 0u) { if (xb_ld(&bar[XB_TMO])) break; if (sp > XB_SPIN_CAP) { atomicAdd(&bar[XB_TMO], 1u); break; } }
    }
    nloc = mine > 0u ? mine : 1u; nx = cnt > 0u ? cnt : 1u;
}
__device__ __forceinline__ void xcd_barrier(const XcdBarrier& b) {
    asm volatile("s_waitcnt vmcnt(0)" ::: "memory");
    __syncthreads();
    if (threadIdx.x == 0) {
        unsigned* bar = b.bar;
        __builtin_amdgcn_s_waitcnt(0);
        unsigned nloc = b.st[0], nx = b.st[1];
        if (nloc == 0u) { xcd_barrier_complete(bar, b.x, nloc, nx); b.st[0] = nloc; b.st[1] = nx; }
        const unsigned old = xb_add(&bar[XB_XSUB(b.x)], 1u);
        const unsigned gen = old / nloc;
        if (old + 1u == (gen + 1u) * nloc) {
            __builtin_amdgcn_fence(__ATOMIC_RELEASE, "agent");
            asm volatile("s_waitcnt vmcnt(0)" ::: "memory");
            const unsigned og = xb_add(&bar[XB_TOP], 1u);
            const unsigned tg = og / nx;
            if (og + 1u == (tg + 1u) * nx) xb_add(&bar[XB_TOPGEN], 1u);
            else XB_SPIN(xb_ld(&bar[XB_TOPGEN]) == tg, bar);
            __builtin_amdgcn_fence(__ATOMIC_ACQUIRE, "agent");
            xb_add(&bar[XB_XGEN(b.x)], 1u);
            asm volatile("s_waitcnt vmcnt(0)" ::: "memory");
        } else {
            XB_SPIN(xb_ld(&bar[XB_XGEN(b.x)]) == gen, bar);
            __builtin_amdgcn_fence(__ATOMIC_ACQUIRE, "agent");
            asm volatile("s_waitcnt vmcnt(0)" ::: "memory");
        }
    }
    __syncthreads();
}

__device__ __forceinline__ float wave_sum(float v) {
#pragma unroll
    for (int o = 1; o < 64; o <<= 1) v += __shfl_xor(v, o);
    return v;
}
__device__ __forceinline__ int t5_bucket(int n) {
    n = n < 0 ? 0 : n;
    if (n < 16) return n;
    const int e = 31 - __clz(n);
    const unsigned nn = (unsigned)n * (unsigned)n;
    const int f = 2 * e + ((nn >> (2 * e + 1)) ? 1 : 0);
    const int b = f + 8;
    return b > 31 ? 31 : b;
}
__device__ __forceinline__ void load_row_bf16(float (&q)[64], const bf16* p) {
    const v4u* p4 = (const v4u*)p;
#pragma unroll
    for (int c = 0; c < 8; ++c) { const v4u w = p4[c];
        q[8 * c + 0] = bf_lo(w.x); q[8 * c + 1] = bf_hi(w.x); q[8 * c + 2] = bf_lo(w.y); q[8 * c + 3] = bf_hi(w.y);
        q[8 * c + 4] = bf_lo(w.z); q[8 * c + 5] = bf_hi(w.z); q[8 * c + 6] = bf_lo(w.w); q[8 * c + 7] = bf_hi(w.w); }
}
__device__ __forceinline__ float dot64(const float (&q)[64], const bf16* p) {
    const v4u* p4 = (const v4u*)p; float s0 = 0.f, s1 = 0.f;
#pragma unroll
    for (int c = 0; c < 8; ++c) { const v4u w = p4[c];
        s0 = fmaf(q[8 * c + 0], bf_lo(w.x), s0); s1 = fmaf(q[8 * c + 1], bf_hi(w.x), s1); s0 = fmaf(q[8 * c + 2], bf_lo(w.y), s0); s1 = fmaf(q[8 * c + 3], bf_hi(w.y), s1);
        s0 = fmaf(q[8 * c + 4], bf_lo(w.z), s0); s1 = fmaf(q[8 * c + 5], bf_hi(w.z), s1); s0 = fmaf(q[8 * c + 6], bf_lo(w.w), s0); s1 = fmaf(q[8 * c + 7], bf_hi(w.w), s1); }
    return s0 + s1;
}
__device__ __forceinline__ void axpy64(float (&acc)[64], float p, const bf16* vp) {
    const v4u* p4 = (const v4u*)vp;
#pragma unroll
    for (int c = 0; c < 8; ++c) { const v4u w = p4[c];
        acc[8 * c + 0] = fmaf(p, bf_lo(w.x), acc[8 * c + 0]); acc[8 * c + 1] = fmaf(p, bf_hi(w.x), acc[8 * c + 1]); acc[8 * c + 2] = fmaf(p, bf_lo(w.y), acc[8 * c + 2]); acc[8 * c + 3] = fmaf(p, bf_hi(w.y), acc[8 * c + 3]);
        acc[8 * c + 4] = fmaf(p, bf_lo(w.z), acc[8 * c + 4]); acc[8 * c + 5] = fmaf(p, bf_hi(w.z), acc[8 * c + 5]); acc[8 * c + 6] = fmaf(p, bf_lo(w.w), acc[8 * c + 6]); acc[8 * c + 7] = fmaf(p, bf_hi(w.w), acc[8 * c + 7]); }
}
__device__ __forceinline__ float dot64f(const float (&q)[64], const float* p) {
    const f32x4* p4 = (const f32x4*)p; float s0 = 0.f, s1 = 0.f;
#pragma unroll
    for (int c = 0; c < 16; ++c) { const f32x4 w = p4[c]; s0 = fmaf(q[4 * c + 0], w.x, s0); s1 = fmaf(q[4 * c + 1], w.y, s1); s0 = fmaf(q[4 * c + 2], w.z, s0); s1 = fmaf(q[4 * c + 3], w.w, s1); }
    return s0 + s1;
}
__device__ __forceinline__ void axpy64f(float (&acc)[64], float p, const float* vp) {
    const f32x4* p4 = (const f32x4*)vp;
#pragma unroll
    for (int c = 0; c < 16; ++c) { const f32x4 w = p4[c]; acc[4 * c + 0] = fmaf(p, w.x, acc[4 * c + 0]); acc[4 * c + 1] = fmaf(p, w.y, acc[4 * c + 1]); acc[4 * c + 2] = fmaf(p, w.z, acc[4 * c + 2]); acc[4 * c + 3] = fmaf(p, w.w, acc[4 * c + 3]); }
}
__device__ __forceinline__ void store_row_f32(float* o, const float (&acc)[64], float sc) {
    f32x4* o4 = (f32x4*)o;
#pragma unroll
    for (int c = 0; c < 16; ++c) o4[c] = (f32x4){acc[4 * c] * sc, acc[4 * c + 1] * sc, acc[4 * c + 2] * sc, acc[4 * c + 3] * sc};
}
__device__ __forceinline__ void rms_row_to_bf16(const float* xrow, const float* g, bf16* orow, int lane) {
    const f32x4* xr = (const f32x4*)xrow + lane; f32x4 v[4]; float s = 0.f;
#pragma unroll
    for (int j = 0; j < 4; ++j) { v[j] = xr[64 * j]; s += (v[j].x * v[j].x + v[j].y * v[j].y) + (v[j].z * v[j].z + v[j].w * v[j].w); }
    const float rstd = rsqrtf(wave_sum(s) * (1.f / DM) + RMS_EPS);
    const f32x4* gr = (const f32x4*)g + lane; v2u* o8 = (v2u*)orow + lane;
#pragma unroll
    for (int j = 0; j < 4; ++j) { const f32x4 gv = gr[64 * j]; v2u w; w.x = pk2(v[j].x * rstd * gv.x, v[j].y * rstd * gv.y); w.y = pk2(v[j].z * rstd * gv.z, v[j].w * rstd * gv.w); o8[64 * j] = w; }
}

struct Args { const float* in[17]; float* out; unsigned char* ws; int ph_lo, ph_hi, li, pad; };
enum { I_X = 0, I_RELB, I_LNAP, I_WIN, I_POS, I_W1, I_B1, I_W2, I_SINK, I_GRPG, I_WOUT, I_LNAPOST, I_LNFP, I_WG, I_WU, I_WD, I_LNFPOST };

__device__ __forceinline__ void p0_prologue(const Args& a, LAS unsigned char* lds, int tid, int lane, int wave) {
    unsigned char* ws = a.ws;
    LAS float* tile = (LAS float*)lds;
    for (int it = blockIdx.x; it < 6400; it += gridDim.x) {
        const int l = it / 3200; int r = it % 3200;
        const int nl = tid & 63;
        const float* W; int ldw, Kd, kt, nt, col; bf16* dst;
        if (r < 576) { kt = r / 36; nt = r % 36; const int n = nt * 64 + nl; W = a.in[I_WIN] + (size_t)l * DM * INW; ldw = INW; Kd = DM;
            col = n < 640 ? n : (n < 2176 ? n + 12 : (n < 2188 ? n - 2176 + 640 : -1)); dst = (bf16*)(ws + WS_WIN) + (size_t)l * INP * DM; }
        else if (r < 832) { r -= 576; kt = r / 16; nt = r % 16; W = a.in[I_WOUT] + (size_t)l * DM * DM; ldw = DM; Kd = DM; col = nt * 64 + nl; dst = (bf16*)(ws + WS_WOUT) + (size_t)l * DM * DM; }
        else if (r < 2240) { r -= 832; kt = r / 88; nt = r % 88; const int n = nt * 64 + nl, t = n >> 7; W = ((t & 1) ? a.in[I_WU] : a.in[I_WG]) + (size_t)l * DM * DFF; ldw = DFF; Kd = DM;
            col = (t >> 1) * 128 + (n & 127); dst = (bf16*)(ws + WS_WGU) + (size_t)l * NGU * DM; }
        else if (r < 2944) { r -= 2240; kt = r / 16; nt = r % 16; W = a.in[I_WD] + (size_t)l * DFF * DM; ldw = DM; Kd = DFF; col = nt * 64 + nl; dst = (bf16*)(ws + WS_WDN) + (size_t)l * DM * DFF; }
        else { r -= 2944; const int kv = r / 128; r %= 128; kt = r / 4; nt = r % 4; W = a.in[I_W1] + (size_t)(l * 2 + kv) * 2048 * 256; ldw = 256; Kd = 2048; col = nt * 64 + nl;
            dst = (bf16*)(ws + WS_W1) + (size_t)(l * 2 + kv) * 256 * 2048; }
#pragma unroll
        for (int i = 0; i < 8; ++i) { const int k = i * 8 + (tid >> 6); tile[k * 65 + nl] = col >= 0 ? W[(size_t)(kt * 64 + k) * ldw + col] : 0.f; }
        __syncthreads();
        { const int rr = tid >> 3, c = tid & 7; const LAS float* s = tile + (8 * c) * 65 + rr;
          v4u o; o.x = pk2(s[0 * 65], s[1 * 65]); o.y = pk2(s[2 * 65], s[3 * 65]); o.z = pk2(s[4 * 65], s[5 * 65]); o.w = pk2(s[6 * 65], s[7 * 65]);
          *(v4u*)(dst + (size_t)(nt * 64 + rr) * Kd + kt * 64 + 8 * c) = o; }
        __syncthreads();
    }
    const int gw = blockIdx.x * NWAVES + wave, NGW = gridDim.x * NWAVES;
    for (int o = gw; o < DEPTH * 2 * 256; o += NGW) { const int lk = o >> 8, n = o & 255; float s = 0.f;
        const float* pos = a.in[I_POS] + (size_t)lk * 2048; const float* w1 = a.in[I_W1] + (size_t)lk * 2048 * 256 + n;
#pragma unroll 8
        for (int i = 0; i < 32; ++i) { const int k = lane + 64 * i; s = fmaf(pos[k], w1[(size_t)k * 256], s); }
        s = wave_sum(s);
        if (lane == 0) ((float*)(ws + WS_POSB))[o] = s + a.in[I_B1][o]; }
    for (int m = gw; m < M; m += NGW) rms_row_to_bf16(a.in[I_X] + (size_t)m * DM, a.in[I_LNAP], (bf16*)(ws + WS_XN) + (size_t)m * DM, lane);
}

__device__ __forceinline__ void p_compress2(const Args& a, int l, int tid) {
    const bf16* hid = (const bf16*)(a.ws + WS_HIDC); float* kvc = (float*)(a.ws + WS_KVC);
    const int NT = gridDim.x * NWAVES * 64;
    for (int idx = blockIdx.x * NWAVES * 64 + tid; idx < 2 * 2048 * 64; idx += NT) {
        const int d = idx & 63, m = (idx >> 6) & 2047, kv = idx >> 17;
        const float* w2 = a.in[I_W2] + (size_t)(l * 2 + kv) * 256 * 64 + d; const bf16* hr = hid + ((size_t)kv * 2048 + m) * 256; float s = 0.f;
#pragma unroll 8
        for (int n = 0; n < 256; ++n) s = fmaf(bf1(hr[n]), w2[n * 64], s);
        kvc[idx] = s;
    }
}

__device__ __forceinline__ void cmp_item(const Args& a, int it, int lane, const LAS float* tab) {
    const bf16* PROJ = (const bf16*)(a.ws + WS_PROJ); const float* KC = (const float*)(a.ws + WS_KVC); const float* VC = KC + 2048 * 64;
    float* OCMP = (float*)(a.ws + WS_OCMP); float* IMP = (float*)(a.ws + WS_IMP);
    const int tl = lane >> 2, h = lane & 3, tok = it * 16 + tl, t = tok & (SEQ - 1);
    const int t0 = __builtin_amdgcn_readfirstlane((it * 16) & (SEQ - 1)), b = __builtin_amdgcn_readfirstlane((it * 16) >> 14);
    float q[64]; load_row_bf16(q, PROJ + (size_t)tok * INP + C_NQ + h * 64);
    const int nc_it = (t0 + 15 >= 31) ? ((t0 + 15 - 31) >> 4) + 1 : 0;
    const float* kcb = KC + (size_t)b * NCP * 64; const float* vcb = VC + (size_t)b * NCP * 64;
    float m = -INFINITY, lsum = 0.f;
    for (int c = 0; c < nc_it; ++c) {
        const int dist = t - (16 * c + 31);
        const float z = dot64f(q, kcb + (size_t)c * 64) * 0.125f + tab[t5_bucket(dist) * 12 + h];
        if (dist >= 0) { const float mn = fmaxf(m, z); lsum = lsum * __expf(m - mn) + __expf(z - mn); m = mn; }
    }
    const float inv_l = lsum > 0.f ? 1.f / lsum : 0.f;
    float acc[64];
#pragma unroll
    for (int d = 0; d < 64; ++d) acc[d] = 0.f;
    float cur = 0.f;
    for (int c = 0; c < nc_it; ++c) {
        const int dist = t - (16 * c + 31);
        const float z = dot64f(q, kcb + (size_t)c * 64) * 0.125f + tab[t5_bucket(dist) * 12 + h];
        const float p = dist >= 0 ? __expf(z - m) * inv_l : 0.f;
        axpy64f(acc, p, vcb + (size_t)c * 64);
        float ps = p + __shfl_xor(p, 1); ps += __shfl_xor(ps, 2);
        if ((c & 3) < 3) cur += ps; else { cur += 0.5f * ps; if (h == 0) IMP[(size_t)tok * 256 + (c >> 2)] = cur; cur = 0.5f * ps; }
    }
    store_row_f32(OCMP + (size_t)tok * 256 + h * 64, acc, 1.f);
}
template <int WIN> __device__ __forceinline__ void band_item(const bf16* PROJ, int tok0, int lane, int cq, int ck, int cv, const LAS float* tab, int bh, bool has_sink, float sink, float* out) {
    const int tok = tok0 + lane, t = tok & (SEQ - 1);
    const int t0 = __builtin_amdgcn_readfirstlane(tok0 & (SEQ - 1)); const size_t rb = (size_t)__builtin_amdgcn_readfirstlane(tok0 - (tok0 & (SEQ - 1)));
    float q[64]; load_row_bf16(q, PROJ + (size_t)tok * INP + cq);
    float acc[64];
#pragma unroll
    for (int d = 0; d < 64; ++d) acc[d] = 0.f;
    float m = has_sink ? sink : -INFINITY, lsum = has_sink ? 1.f : 0.f;
    const int s_lo = t0 - (WIN - 1) > 0 ? t0 - (WIN - 1) : 0;
    for (int s = s_lo; s <= t0 + 63; ++s) {
        const bf16* row = PROJ + (rb + (size_t)s) * INP;
        const int dist = t - s;
        float z = dot64(q, row + ck) * 0.125f;
        if (dist >= 0 && dist < WIN) {
            z += tab[t5_bucket(dist) * 12 + bh];
            if (z > m) { const float sc = __expf(m - z); lsum *= sc;
#pragma unroll
                for (int d = 0; d < 64; ++d) acc[d] *= sc;
                m = z; }
            const float p = __expf(z - m); lsum += p; axpy64(acc, p, row + cv);
        }
    }
    store_row_f32(out, acc, 1.f / lsum);
}
__device__ __forceinline__ void sb_item(const bf16* PROJ, int tok0, int lane, int h, float* out) {
    const int tok = tok0 + lane, t = tok & (SEQ - 1);
    const int t0 = __builtin_amdgcn_readfirstlane(tok0 & (SEQ - 1)); const size_t rb = (size_t)__builtin_amdgcn_readfirstlane(tok0 - (tok0 & (SEQ - 1)));
    float q[64]; load_row_bf16(q, PROJ + (size_t)tok * INP + C_BQ + h * 64);
    float acc[64];
#pragma unroll
    for (int d = 0; d < 64; ++d) acc[d] = 0.f;
    float later = 0.f;
    for (int s = t0 + 62; s >= 0; --s) {
        const bf16* row = PROJ + (rb + (size_t)s) * INP;
        const float z = dot64(q, row + C_BK + h * 64) * 0.125f;
        if (s < t) {
            const float sp = fmaxf(z, 0.f) + __logf(1.f + __expf(-fabsf(z)));
            const float aw = __expf(z - sp + later);
            axpy64(acc, aw, row + C_BV + h * 64);
            later -= sp;
        }
        if (s < t0 && __all(later < -104.f)) break;
    }
    store_row_f32(out, acc, 1.f);
}
__device__ __forceinline__ void p_attn_a(const Args& a, int l, LAS unsigned char* lds, int tid, int lane, int wave) {
    LAS float* tab = (LAS float*)lds;
    if (tid < 384) tab[tid] = a.in[I_RELB][tid];
    __syncthreads();
    const bf16* PROJ = (const bf16*)(a.ws + WS_PROJ);
    const int gw = blockIdx.x * NWAVES + wave, NGW = gridDim.x * NWAVES;
    for (int it = gw; it < M / 16; it += NGW) cmp_item(a, (M / 16 - 1) - it, lane, tab);
    for (int it = gw; it < (M / 64) * 4; it += NGW) { const int tile = it >> 2, h = it & 3;
        band_item<512>(PROJ, tile * 64, lane, C_NQ + h * 64, C_KW, C_VW, tab, h, false, 0.f, (float*)(a.ws + WS_OWIN) + (size_t)(tile * 64 + lane) * 256 + h * 64); }
    for (int it = gw; it < (M / 64) * 8; it += NGW) { const int tile = it >> 3, hq = it & 7;
        band_item<128>(PROJ, tile * 64, lane, C_SQ + hq * 64, C_SK + (hq >> 2) * 64, C_SV + (hq >> 2) * 64, tab, 4 + hq, true, a.in[I_SINK][l * 8 + hq], (float*)(a.ws + WS_OSWA) + (size_t)(tile * 64 + lane) * 512 + hq * 64); }
    for (int it = gw; it < (M / 64) * 4; it += NGW) { const int tile = it >> 2, h = it & 3;
        sb_item(PROJ, tile * 64, lane, h, (float*)(a.ws + WS_OSB) + (size_t)(tile * 64 + lane) * 256 + h * 64); }
}
__device__ __forceinline__ void p_attn_b(const Args& a, LAS unsigned char* lds, int tid, int lane, int wave) {
    LAS float* tab = (LAS float*)lds; LAS int* idxL = (LAS int*)(lds + 2048) + wave * 256;
    if (tid < 384) tab[tid] = a.in[I_RELB][tid];
    __syncthreads();
    const bf16* PROJ = (const bf16*)(a.ws + WS_PROJ); const float* IMP = (const float*)(a.ws + WS_IMP); float* OSLC = (float*)(a.ws + WS_OSLC);
    const int gw = blockIdx.x * NWAVES + wave, NGW = gridDim.x * NWAVES;
    for (int it = gw; it < M / 16; it += NGW) {
        for (int tl = 0; tl < 16; ++tl) {
            const int tok = it * 16 + tl, t = tok & (SEQ - 1), cur = t >> 6;
            int my = -1;
            if (cur <= 15) { my = lane <= cur ? lane : -1; }
            else {
                float v[4];
#pragma unroll
                for (int i = 0; i < 4; ++i) { const int j = lane + 64 * i; v[i] = (j >= 1 && j <= cur - 2) ? IMP[(size_t)tok * 256 + j] : -INFINITY; }
                if (lane == 0) my = 0; else if (lane == 1) my = cur - 1; else if (lane == 2) my = cur;
                for (int r = 0; r < 13; ++r) {
                    float bv = v[0]; int bj = lane;
#pragma unroll
                    for (int i = 1; i < 4; ++i) if (v[i] > bv) { bv = v[i]; bj = lane + 64 * i; }
#pragma unroll
                    for (int o = 1; o < 64; o <<= 1) { const float ov = __shfl_xor(bv, o); const int oj = __shfl_xor(bj, o); if (ov > bv || (ov == bv && oj < bj)) { bv = ov; bj = oj; } }
                    if (lane == 3 + r) my = bj;
#pragma unroll
                    for (int i = 0; i < 4; ++i) if (lane + 64 * i == bj) v[i] = -INFINITY;
                }
            }
            if (lane < 16) idxL[tl * 16 + lane] = my;
        }
        LDS_WAIT();
        const int tl = lane >> 2, h = lane & 3, tok = it * 16 + tl, t = tok & (SEQ - 1);
        const size_t rb = (size_t)((it * 16) - ((it * 16) & (SEQ - 1)));
        float q[64]; load_row_bf16(q, PROJ + (size_t)tok * INP + C_NQ + h * 64);
        float acc[64];
#pragma unroll
        for (int d = 0; d < 64; ++d) acc[d] = 0.f;
        float m = -INFINITY, lsum = 0.f;
        for (int k = 0; k < 16; ++k) {
            const int blk = idxL[tl * 16 + k];
            for (int kk = 0; kk < 64; ++kk) {
                const int pos = blk * 64 + kk;
                if (blk >= 0 && pos <= t) {
                    const bf16* row = PROJ + (rb + (size_t)pos) * INP;
                    const float z = dot64(q, row + C_KS) * 0.125f + tab[t5_bucket(t - pos) * 12 + h];
                    if (z > m) { const float sc = __expf(m - z); lsum *= sc;
#pragma unroll
                        for (int d = 0; d < 64; ++d) acc[d] *= sc;
                        m = z; }
                    const float p = __expf(z - m); lsum += p; axpy64(acc, p, row + C_VS);
                }
            }
        }
        store_row_f32(OSLC + (size_t)tok * 256 + h * 64, acc, 1.f / lsum);
        LDS_WAIT();
    }
}
__device__ __forceinline__ void p_groupnorm(const Args& a, int l, int lane, int wave) {
    const bf16* PROJ = (const bf16*)(a.ws + WS_PROJ); bf16* MIX = (bf16*)(a.ws + WS_XN); const float* gg = a.in[I_GRPG] + (size_t)l * DM;
    const int gw = blockIdx.x * NWAVES + wave, NGW = gridDim.x * NWAVES;
    for (int tok = gw; tok < M; tok += NGW) {
        const int hd = lane >> 4; const bf16* gl = PROJ + (size_t)tok * INP + C_NG;
        const float g0 = 1.f / (1.f + __expf(-bf1(gl[hd]))), g1 = 1.f / (1.f + __expf(-bf1(gl[4 + hd]))), g2 = 1.f / (1.f + __expf(-bf1(gl[8 + hd])));
        const f32x4 oc = *((const f32x4*)((const float*)(a.ws + WS_OCMP) + (size_t)tok * 256) + lane), os = *((const f32x4*)((const float*)(a.ws + WS_OSLC) + (size_t)tok * 256) + lane),
                    ow = *((const f32x4*)((const float*)(a.ws + WS_OWIN) + (size_t)tok * 256) + lane);
        const f32x4 v = oc * g0 + os * g1 + ow * g2;
        float rstd = rsqrtf(wave_sum((v.x * v.x + v.y * v.y) + (v.z * v.z + v.w * v.w)) * (1.f / 256.f) + RMS_EPS);
        f32x4 gv = *((const f32x4*)gg + lane);
        v2u w; w.x = pk2(v.x * rstd * gv.x, v.y * rstd * gv.y); w.y = pk2(v.z * rstd * gv.z, v.w * rstd * gv.w);
        *((v2u*)(MIX + (size_t)tok * DM) + lane) = w;
        const f32x4 s0 = *((const f32x4*)((const float*)(a.ws + WS_OSWA) + (size_t)tok * 512) + 2 * lane), s1 = *((const f32x4*)((const float*)(a.ws + WS_OSWA) + (size_t)tok * 512) + 2 * lane + 1);
        rstd = rsqrtf(wave_sum(((s0.x * s0.x + s0.y * s0.y) + (s0.z * s0.z + s0.w * s0.w)) + ((s1.x * s1.x + s1.y * s1.y) + (s1.z * s1.z + s1.w * s1.w))) * (1.f / 512.f) + RMS_EPS);
        const f32x4 ga = *((const f32x4*)(gg + 256) + 2 * lane), gb = *((const f32x4*)(gg + 256) + 2 * lane + 1);
        v4u w4; w4.x = pk2(s0.x * rstd * ga.x, s0.y * rstd * ga.y); w4.y = pk2(s0.z * rstd * ga.z, s0.w * rstd * ga.w); w4.z = pk2(s1.x * rstd * gb.x, s1.y * rstd * gb.y); w4.w = pk2(s1.z * rstd * gb.z, s1.w * rstd * gb.w);
        *((v4u*)(MIX + (size_t)tok * DM + 256) + lane) = w4;
        const f32x4 sb = *((const f32x4*)((const float*)(a.ws + WS_OSB) + (size_t)tok * 256) + lane);
        rstd = rsqrtf(wave_sum((sb.x * sb.x + sb.y * sb.y) + (sb.z * sb.z + sb.w * sb.w)) * (1.f / 256.f) + RMS_EPS);
        gv = *((const f32x4*)(gg + 768) + lane);
        w.x = pk2(sb.x * rstd * gv.x, sb.y * rstd * gv.y); w.y = pk2(sb.z * rstd * gv.z, sb.w * rstd * gv.w);
        *((v2u*)(MIX + (size_t)tok * DM + 768) + lane) = w;
    }
}
__device__ __forceinline__ void p_postnorm(const Args& a, const float* xold, const float* gpost, const float* gnext, int lane, int wave) {
    const bf16* F = (const bf16*)(a.ws + WS_F); bf16* XN = (bf16*)(a.ws + WS_XN);
    const int gw = blockIdx.x * NWAVES + wave, NGW = gridDim.x * NWAVES;
    for (int tok = gw; tok < M; tok += NGW) {
        f32x4 f[4]; float s = 0.f;
#pragma unroll
        for (int j = 0; j < 4; ++j) { const v2u w = *((const v2u*)(F + (size_t)tok * DM) + lane + 64 * j); f[j] = (f32x4){bf_lo(w.x), bf_hi(w.x), bf_lo(w.y), bf_hi(w.y)};
            s += (f[j].x * f[j].x + f[j].y * f[j].y) + (f[j].z * f[j].z + f[j].w * f[j].w); }
        const float rstd = rsqrtf(wave_sum(s) * (1.f / DM) + RMS_EPS);
        float s2 = 0.f;
#pragma unroll
        for (int j = 0; j < 4; ++j) { const f32x4 xo = *((const f32x4*)(xold + (size_t)tok * DM) + lane + 64 * j); const f32x4 gp = *((const f32x4*)gpost + lane + 64 * j);
            f[j] = xo + f[j] * rstd * gp; *((f32x4*)(a.out + (size_t)tok * DM) + lane + 64 * j) = f[j];
            s2 += (f[j].x * f[j].x + f[j].y * f[j].y) + (f[j].z * f[j].z + f[j].w * f[j].w); }
        if (gnext) { const float r2 = rsqrtf(wave_sum(s2) * (1.f / DM) + RMS_EPS);
#pragma unroll
            for (int j = 0; j < 4; ++j) { const f32x4 gn = *((const f32x4*)gnext + lane + 64 * j); v2u w; w.x = pk2(f[j].x * r2 * gn.x, f[j].y * r2 * gn.y); w.y = pk2(f[j].z * r2 * gn.z, f[j].w * r2 * gn.w);
                *((v2u*)(XN + (size_t)tok * DM) + lane + 64 * j) = w; } }
    }
}

__global__ void __launch_bounds__(NWAVES * 64, 2) hyb_fwd(Args args) {
    extern __shared__ __attribute__((aligned(16))) unsigned char lds_raw[];
    LAS unsigned char* lds = (LAS unsigned char*)lds_raw;
    const int tid = threadIdx.x, lane = tid & 63, wave = __builtin_amdgcn_readfirstlane(tid >> 6);
    const int G = gridDim.x;
    for (int u = tid; u < (LDS_BYTES - LDSCTL_OFF) / 4; u += NWAVES * 64) ((LAS unsigned*)(lds + LDSCTL_OFF))[u] = 0u;
    __syncthreads();
    unsigned* ctl = (unsigned*)(args.ws + WS_CTL);
    XcdBarrier bar = xcd_barrier_post(ctl + CW_BAR + args.li * XCD_BAR_WORDS, (volatile LAS unsigned*)(lds + MISC_OFF) + 8);
    const int lo = args.ph_lo, hi = args.ph_hi;
#define IN(k) (lo <= (k) && (k) < hi)
#define LAUNDER int tid_ = tid; asm volatile("" : "+v"(tid_)); const int lane_ = tid_ & 63, wave_ = __builtin_amdgcn_readfirstlane(tid_ >> 6)
#define SEAM(k) do { if ((k) + 1 < hi) xcd_barrier(bar); else { VM_WAIT(); __syncthreads(); } } while (0)
    unsigned char* ws = args.ws;
    if ((PHMASK & 1) && IN(0)) { LAUNDER; p0_prologue(args, lds, tid_, lane_, wave_); SEAM(0); }
    for (int l = 0; l < DEPTH; ++l) {
        const int pb = 1 + 11 * l;
        if (((PHMASK >> 1) & 1) && IN(pb + 0)) {
            pg8::Gemm g{(const pg8::bf16_t*)(ws + WS_XN), (const pg8::bf16_t*)(ws + WS_WIN) + (size_t)l * INP * DM, M, INP, DM, (size_t)DM * 2, 128};
            pg8::StaticOrder S; S.init(M, INP, G, (int)blockIdx.x);
            pg8::EpiBf16<0> E{(pg8::bf16_t*)(ws + WS_PROJ), INP, nullptr};
            pg8::gemm_phase<pg8::EpiBf16<0>, pg8::StaticOrder, true, true>(lds + RING_OFF, g, S, E);
            SEAM(pb + 0);
        }
        if (((PHMASK >> 2) & 1) && IN(pb + 1)) {
            pg8::StaticOrder S; S.init(2 * NCP, 256, G, (int)blockIdx.x);
            { pg8::Gemm g{(const pg8::bf16_t*)(ws + WS_PROJ) + C_KC, (const pg8::bf16_t*)(ws + WS_W1) + (size_t)(l * 2 + 0) * 256 * 2048, 2 * NCP, 256, 2048, (size_t)16 * INP * 2, (size_t)INP * 2};
              pg8::EpiBf16<2> E{(pg8::bf16_t*)(ws + WS_HIDC), 256, (const float*)(ws + WS_POSB) + (l * 2 + 0) * 256};
              pg8::gemm_phase<pg8::EpiBf16<2>, pg8::StaticOrder, true, true>(lds + RING_OFF, g, S, E); }
            pg8::StaticOrder S2; S2.init(2 * NCP, 256, G, (int)((blockIdx.x + G / 2) % G));
            { pg8::Gemm g{(const pg8::bf16_t*)(ws + WS_PROJ) + C_VC, (const pg8::bf16_t*)(ws + WS_W1) + (size_t)(l * 2 + 1) * 256 * 2048, 2 * NCP, 256, 2048, (size_t)16 * INP * 2, (size_t)INP * 2};
              pg8::EpiBf16<2> E{(pg8::bf16_t*)(ws + WS_HIDC) + (size_t)2 * NCP * 256, 256, (const float*)(ws + WS_POSB) + (l * 2 + 1) * 256};
              pg8::gemm_phase<pg8::EpiBf16<2>, pg8::StaticOrder, true, true>(lds + RING_OFF, g, S2, E); }
            SEAM(pb + 1);
        }
        if (((PHMASK >> 3) & 1) && IN(pb + 2)) { LAUNDER; p_compress2(args, l, tid_); SEAM(pb + 2); }
        if (((PHMASK >> 4) & 1) && IN(pb + 3)) { LAUNDER; p_attn_a(args, l, lds, tid_, lane_, wave_); SEAM(pb + 3); }
        if (((PHMASK >> 5) & 1) && IN(pb + 4)) { LAUNDER; p_attn_b(args, lds, tid_, lane_, wave_); SEAM(pb + 4); }
        if (((PHMASK >> 6) & 1) && IN(pb + 5)) { LAUNDER; p_groupnorm(args, l, lane_, wave_); SEAM(pb + 5); }
        if (((PHMASK >> 7) & 1) && IN(pb + 6)) {
            pg8::Gemm g{(const pg8::bf16_t*)(ws + WS_XN), (const pg8::bf16_t*)(ws + WS_WOUT) + (size_t)l * DM * DM, M, DM, DM, (size_t)DM * 2, 128};
            pg8::StaticOrder S; S.init(M, DM, G, (int)blockIdx.x);
            pg8::EpiBf16<0> E{(pg8::bf16_t*)(ws + WS_F), DM, nullptr};
            pg8::gemm_phase<pg8::EpiBf16<0>, pg8::StaticOrder, true, true>(lds + RING_OFF, g, S, E);
            SEAM(pb + 6);
        }
        if (((PHMASK >> 8) & 1) && IN(pb + 7)) {
            LAUNDER; p_postnorm(args, l == 0 ? args.in[I_X] : args.out, args.in[I_LNAPOST] + (size_t)l * DM, args.in[I_LNFP] + (size_t)l * DM, lane_, wave_); SEAM(pb + 7);
        }
        if (((PHMASK >> 9) & 1) && IN(pb + 8)) {
            pg8::Gemm g{(const pg8::bf16_t*)(ws + WS_XN), (const pg8::bf16_t*)(ws + WS_WGU) + (size_t)l * NGU * DM, M, NGU, DM, (size_t)DM * 2, 128};
            pg8::StaticOrder S; S.init(M, NGU, G, (int)blockIdx.x);
            pg8::EpiSwiGLU E{(pg8::bf16_t*)(ws + WS_HID), DFF};
            pg8::gemm_phase<pg8::EpiSwiGLU, pg8::StaticOrder, true, true>(lds + RING_OFF, g, S, E);
            SEAM(pb + 8);
        }
        if (((PHMASK >> 10) & 1) && IN(pb + 9)) {
            pg8::Gemm g{(const pg8::bf16_t*)(ws + WS_HID), (const pg8::bf16_t*)(ws + WS_WDN) + (size_t)l * DM * DFF, M, DM, DFF, (size_t)DFF * 2, 128};
            pg8::StaticOrder S; S.init(M, DM, G, (int)blockIdx.x);
            pg8::EpiBf16<0> E{(pg8::bf16_t*)(ws + WS_F), DM, nullptr};
            pg8::gemm_phase<pg8::EpiBf16<0>, pg8::StaticOrder, true, true>(lds + RING_OFF, g, S, E);
            SEAM(pb + 9);
        }
        if (((PHMASK >> 11) & 1) && IN(pb + 10)) {
            LAUNDER; p_postnorm(args, args.out, args.in[I_LNFPOST] + (size_t)l * DM, l + 1 < DEPTH ? args.in[I_LNAP] + (size_t)(l + 1) * DM : nullptr, lane_, wave_); SEAM(pb + 10);
        }
    }
#undef IN
#undef SEAM
}

#ifndef PHMASK
#define PHMASK 0xFFF
#endif
#ifndef MK_ONE_LAUNCH
#define MK_ONE_LAUNCH 1
#endif
extern "C" void kernel_launch(void* const* d_in, const int* in_sizes, int n_in, void* d_out, int out_size, void* d_ws, size_t ws_size, hipStream_t stream) {
    static int grid = 0;
    if (grid == 0) {
        if (n_in != 17 || in_sizes[0] != M * DM || out_size != M * DM || ws_size < WS_END) { fprintf(stderr, "kernel_launch: unexpected shapes (n_in %d, in0 %d, out %d, ws %zu); nothing launched\n", n_in, n_in > 0 ? in_sizes[0] : -1, out_size, ws_size); grid = -1; return; }
        int dev = 0, cus = 0, per_cu = 0;
        if (hipGetDevice(&dev) != hipSuccess || hipDeviceGetAttribute(&cus, hipDeviceAttributeMultiprocessorCount, dev) != hipSuccess) { grid = -1; return; }
        if (hipFuncSetAttribute((const void*)hyb_fwd, hipFuncAttributeMaxDynamicSharedMemorySize, LDS_BYTES) != hipSuccess) { fprintf(stderr, "kernel_launch: hipFuncSetAttribute failed\n"); grid = -1; return; }
        if (hipOccupancyMaxActiveBlocksPerMultiprocessor(&per_cu, (const void*)hyb_fwd, NWAVES * 64, LDS_BYTES) != hipSuccess || per_cu < 1) fprintf(stderr, "kernel_launch: occupancy query reports %d workgroups per CU\n", per_cu);
        (void)hipGetLastError();
        grid = cus;
    }
    if (grid < 0) return;
    if (hipMemsetAsync((char*)d_ws + WS_CTL, 0, CTL_ZERO_BYTES, stream) != hipSuccess) return;
    Args a{};
    for (int i = 0; i < 17; ++i) a.in[i] = (const float*)d_in[i];
    a.out = (float*)d_out; a.ws = (unsigned char*)d_ws;
#if MK_ONE_LAUNCH
    a.ph_lo = 0; a.ph_hi = NPH; a.li = 0;
    hipLaunchKernelGGL(hyb_fwd, dim3(grid), dim3(NWAVES * 64), LDS_BYTES, stream, a);
#else
    for (int p = 0; p < NPH; ++p) { a.ph_lo = p; a.ph_hi = p + 1; a.li = p;
        hipLaunchKernelGGL(hyb_fwd, dim3(grid), dim3(NWAVES * 64), LDS_BYTES, stream, a); }
#endif
}
```

```cpp
#include <hip/hip_runtime.h>
#include <cstdio>
#include <cstdint>
#ifndef PHMASK
#define PHMASK 0xFFF
#endif
#ifndef USE_MFMA_A
#define USE_MFMA_A 1
#endif
#ifndef REPMASK
#define REPMASK 0
#endif
namespace pg8 {
#define PG8_LAS __attribute__((address_space(3)))
typedef unsigned short bf16_t;
typedef short bf16x8 __attribute__((ext_vector_type(8)));
typedef float f32x4 __attribute__((ext_vector_type(4)));
typedef unsigned u32x4 __attribute__((ext_vector_type(4)));
constexpr int BM = 256, BK = 64, HALF = 128, HTB = HALF * BK * 2  , STAGE_BYTES = 8 * HTB, NXCD = 8, WGM = 8;

__host__ __device__ __forceinline__ int lds_byte(int r, int c) { const int st = (r >> 4) * 2 + (c >> 5), rr = r & 15, cc = c & 31, ob = rr * 64 + cc * 2; return st * 1024 + (ob ^ (((ob >> 9) & 1) << 5)); }
__host__ __device__ __forceinline__ void stage_rc(int b, int& R, int& C) { const int st = b / 1024, sb = b % 1024, swz = sb ^ (((sb >> 9) & 1) << 5); R = (st >> 1) * 16 + swz / 64; C = (st & 1) * 32 + (swz % 64) / 2; }
__host__ __device__ __forceinline__ int perm32(int rho) { const int n = rho >> 4, i = rho & 15; return 8 * (i >> 2) + 4 * n + (i & 3); }

struct Unit { int pm, pn; };
struct Gemm { const bf16_t* A; const bf16_t* Bt; int M, N, K; size_t a_row_bytes, a_kstep_bytes; };

struct StaticOrder {
    int nM, nN, nwg, G, c;
    __host__ __device__ void init(int M, int N, int G_, int c_) { nM = M / BM; nN = N / BM; nwg = nM * nN; G = G_; c = c_; }
    __host__ __device__ bool next(int i, Unit& u) const {
        const long L = (long)i * G + c; if (L >= nwg) return false;
        int wgid = (int)L; { const int q = nwg / NXCD, r = nwg % NXCD, xcd = wgid % NXCD, off = wgid / NXCD; wgid = (xcd < r ? xcd * (q + 1) : r * (q + 1) + (xcd - r) * q) + off; }
        const int nig = WGM * nN, gid = wgid / nig, fm = gid * WGM, gsz = (nM - fm) < WGM ? (nM - fm) : WGM;
        u.pm = fm + ((wgid % nig) % gsz); u.pn = (wgid % nig) / gsz; return true;
    }
    __device__ __forceinline__ void a_ready(const Unit&) const {}
    __device__ __forceinline__ void done(const Unit&) const {}
};

__device__ __forceinline__ unsigned cvt_pk_bf16(float lo, float hi) { unsigned r; asm volatile("v_cvt_pk_bf16_f32 %0, %1, %2" : "=v"(r) : "v"(lo), "v"(hi)); return r; }
typedef float f32x2 __attribute__((ext_vector_type(2)));
__device__ __forceinline__ float silu_f(float x) { return x * __builtin_amdgcn_rcpf(1.0f + __expf(-x)); }
template <int ACT  > struct EpiBf16 {
    static constexpr bool PERM = true, AFTER_DRAIN = false;
    bf16_t* O; int ldc; const float* bias;
    __device__ __forceinline__ void operator()(const f32x4 (&acc)[2][2][4][2], const Unit& u, int wr, int wc, int fr, int fq) const {
        const int row0 = u.pm * BM + wr * 64 + fr; const int col0 = u.pn * BM + wc * 32 + 8 * fq;
        f32x4 bv[2][2];
#pragma unroll
        for (int bj = 0; bj < 2; ++bj)
#pragma unroll
            for (int n = 0; n < 2; ++n) bv[bj][n] = bias ? *(const f32x4*)(bias + col0 + bj * HALF + 4 * n) : (f32x4){0.f, 0.f, 0.f, 0.f};
#pragma unroll
        for (int ai = 0; ai < 2; ++ai)
#pragma unroll
            for (int m = 0; m < 4; ++m) { bf16_t* rowp = O + (size_t)(row0 + ai * HALF + m * 16) * ldc + col0;
#pragma unroll
                for (int bj = 0; bj < 2; ++bj) { f32x4 v0 = acc[ai][bj][m][0] + bv[bj][0], v1 = acc[ai][bj][m][1] + bv[bj][1];
                    if (ACT == 2) { v0 = (f32x4){silu_f(v0[0]), silu_f(v0[1]), silu_f(v0[2]), silu_f(v0[3])}; v1 = (f32x4){silu_f(v1[0]), silu_f(v1[1]), silu_f(v1[2]), silu_f(v1[3])}; }
                    u32x4 w; w.x = cvt_pk_bf16(v0[0], v0[1]); w.y = cvt_pk_bf16(v0[2], v0[3]); w.z = cvt_pk_bf16(v1[0], v1[1]); w.w = cvt_pk_bf16(v1[2], v1[3]);
                    *(u32x4*)(rowp + bj * HALF) = w; } }
    }
};
struct EpiSwiGLU {
    static constexpr bool PERM = true, AFTER_DRAIN = false;
    bf16_t* O; int ldc;
    __device__ __forceinline__ void operator()(const f32x4 (&acc)[2][2][4][2], const Unit& u, int wr, int wc, int fr, int fq) const {
        const int row0 = u.pm * BM + wr * 64 + fr; const int col0 = u.pn * HALF + wc * 32 + 8 * fq;
#pragma unroll
        for (int ai = 0; ai < 2; ++ai)
#pragma unroll
            for (int m = 0; m < 4; ++m) { bf16_t* rowp = O + (size_t)(row0 + ai * HALF + m * 16) * ldc + col0;
                const f32x4 g0 = acc[ai][0][m][0], g1 = acc[ai][0][m][1], u0 = acc[ai][1][m][0], u1 = acc[ai][1][m][1];
                u32x4 w; w.x = cvt_pk_bf16(silu_f(g0[0]) * u0[0], silu_f(g0[1]) * u0[1]); w.y = cvt_pk_bf16(silu_f(g0[2]) * u0[2], silu_f(g0[3]) * u0[3]);
                w.z = cvt_pk_bf16(silu_f(g1[0]) * u1[0], silu_f(g1[1]) * u1[1]); w.w = cvt_pk_bf16(silu_f(g1[2]) * u1[2], silu_f(g1[3]) * u1[3]);
                *(u32x4*)rowp = w; }
    }
};
template <class Epi, class Sched, bool ALIGN_EPI = false, bool SP2 = false>
__device__ __forceinline__ void gemm_phase(PG8_LAS unsigned char* lds, const Gemm g, const Sched& S, const Epi& E) {
    int tid_l = threadIdx.x; asm volatile("" : "+v"(tid_l));
    const int tid = tid_l, wid = __builtin_amdgcn_readfirstlane(tid >> 6), lane = tid & 63, wr = wid >> 2, wc = wid & 3, fr = lane & 15, fq = lane >> 4;
    const int K = g.K, nt = K / BK;
    unsigned voffA[2], voffB[2];
#pragma unroll
    for (int i = 0; i < 2; ++i) { int R, C; stage_rc(tid * 16 + i * 8192, R, C); const int Rb = Epi::PERM ? ((R & ~31) + perm32(R & 31)) : R;
        voffA[i] = (unsigned)((size_t)R * g.a_row_bytes + (size_t)C * 2u); voffB[i] = (unsigned)(Rb * K + C) * 2u; }
    const size_t kstepB = (size_t)(BK * 2), kstepA = g.a_kstep_bytes;
    const size_t hstepB = (size_t)HALF * K * 2, hstepA = (size_t)HALF * g.a_row_bytes;
    const size_t tstepB = 2 * hstepB, tstepA = 2 * hstepA;
    const unsigned ldsw = (unsigned)wid * 1024u;
    const int aoff = lds_byte(wr * 64 + fr, fq * 8), boff = lds_byte(wc * 32 + fr, fq * 8);
#define PG8_SA(b, h) (((b) * 2 + (h)) * HTB)
#define PG8_SB(b, h) ((4 + (b) * 2 + (h)) * HTB)
#define PG8_STAGE(bufoff, gbase, voff) do { _Pragma("unroll") for (int _i = 0; _i < 2; ++_i) \
        __builtin_amdgcn_global_load_lds((const unsigned*)((const char*)(gbase) + (voff)[_i]), (PG8_LAS unsigned*)(lds + (bufoff) + ldsw + _i * 8192), 16, 0, 0); } while (0)
#define PG8_LDA(dst, b, h) do { _Pragma("unroll") for (int m = 0; m < 4; ++m) _Pragma("unroll") for (int k = 0; k < 2; ++k) dst[m][k] = *(const PG8_LAS bf16x8*)(lds + PG8_SA(b, h) + aoff + m * 2048 + k * 1024); } while (0)
#define PG8_LDB(dst, b, h) do { _Pragma("unroll") for (int n = 0; n < 2; ++n) _Pragma("unroll") for (int k = 0; k < 2; ++k) dst[n][k] = *(const PG8_LAS bf16x8*)(lds + PG8_SB(b, h) + boff + n * 2048 + k * 1024); } while (0)
#define PG8_MMA(ai, bj, At, Bt) do { __builtin_amdgcn_s_setprio(1); _Pragma("unroll") for (int m = 0; m < 4; ++m) _Pragma("unroll") for (int n = 0; n < 2; ++n) _Pragma("unroll") for (int k = 0; k < 2; ++k) \
        acc[ai][bj][m][n] = __builtin_amdgcn_mfma_f32_16x16x32_bf16(Bt[n][k], At[m][k], acc[ai][bj][m][n], 0, 0, 0); __builtin_amdgcn_s_setprio(0); } while (0)
#define PG8_WAIT_V(n) asm volatile("s_waitcnt vmcnt(" #n ")" ::: "memory")
#define PG8_WAIT_L(n) asm volatile("s_waitcnt lgkmcnt(" #n ")" ::: "memory")
#define PG8_BAR __builtin_amdgcn_s_barrier()
#define PG8_SCHED __builtin_amdgcn_sched_barrier(0)
    Unit cur, nxt; int ui = 0;
    if (!S.next(0, cur)) return;
    f32x4 acc[2][2][4][2];
#pragma unroll
    for (int a = 0; a < 2; ++a)
#pragma unroll
        for (int b = 0; b < 2; ++b)
#pragma unroll
            for (int m = 0; m < 4; ++m)
#pragma unroll
                for (int n = 0; n < 2; ++n) acc[a][b][m][n] = (f32x4){0.f, 0.f, 0.f, 0.f};
    bf16x8 At[4][2], B0[2][2], B1[2][2];
    const char* cA = (const char*)g.A + (size_t)cur.pm * tstepA; const char* cB = (const char*)g.Bt + (size_t)cur.pn * tstepB;
    S.a_ready(cur);
    if constexpr (SP2) {
        PG8_STAGE(PG8_SB(0, 0), cB, voffB); PG8_STAGE(PG8_SB(0, 1), cB + hstepB, voffB); PG8_STAGE(PG8_SA(0, 0), cA, voffA); PG8_STAGE(PG8_SA(0, 1), cA + hstepA, voffA);
        if (wr == 1) PG8_BAR;
        PG8_WAIT_V(2); PG8_BAR;
        PG8_STAGE(PG8_SB(1, 0), cB + kstepB, voffB); PG8_STAGE(PG8_SA(1, 0), cA + kstepA, voffA); PG8_STAGE(PG8_SB(1, 1), cB + hstepB + kstepB, voffB);
        PG8_WAIT_V(6); PG8_BAR;
    } else {
        PG8_STAGE(PG8_SB(0, 0), cB, voffB); PG8_STAGE(PG8_SA(0, 0), cA, voffA); PG8_STAGE(PG8_SB(0, 1), cB + hstepB, voffB); PG8_STAGE(PG8_SA(0, 1), cA + hstepA, voffA);
        if (wr == 1) PG8_BAR;
        PG8_WAIT_V(4); PG8_BAR;
        PG8_STAGE(PG8_SB(1, 0), cB + kstepB, voffB); PG8_STAGE(PG8_SA(1, 0), cA + kstepA, voffA); PG8_STAGE(PG8_SB(1, 1), cB + hstepB + kstepB, voffB);
        PG8_WAIT_V(6); PG8_BAR;
    }
    for (;;) {
        const bool has_next = S.next(ui + 1, nxt);
        const char* nA = has_next ? (const char*)g.A + (size_t)nxt.pm * tstepA : cA; const char* nB = has_next ? (const char*)g.Bt + (size_t)nxt.pn * tstepB : cB;
        for (int t = 0; t < nt; t += 2) {
            const bool last = (t == nt - 2);
            const char* a1 = cA + (size_t)(t + 1) * kstepA;
            const char* a2 = last ? nA : cA + (size_t)(t + 2) * kstepA; const char* b2 = last ? nB : cB + (size_t)(t + 2) * kstepB;
            const char* a3 = a2 + kstepA; const char* b3 = b2 + kstepB;
            if (last && has_next) S.a_ready(nxt);
            if constexpr (SP2) {
            PG8_LDB(B0, 0, 0); PG8_LDB(B1, 0, 1); PG8_SCHED; PG8_LDA(At, 0, 0); PG8_STAGE(PG8_SA(1, 1), a1 + hstepA, voffA);
            PG8_WAIT_V(8); PG8_WAIT_L(0); PG8_BAR; PG8_MMA(0, 0, At, B0); PG8_MMA(0, 1, At, B1); PG8_BAR; PG8_SCHED;
            PG8_LDA(At, 0, 1); PG8_STAGE(PG8_SB(0, 0), b2, voffB); PG8_STAGE(PG8_SB(0, 1), b2 + hstepB, voffB); PG8_STAGE(PG8_SA(0, 0), a2, voffA);
            PG8_WAIT_V(8); PG8_WAIT_L(0); PG8_BAR; PG8_MMA(1, 0, At, B0); PG8_MMA(1, 1, At, B1); PG8_BAR; PG8_SCHED;
            PG8_LDB(B0, 1, 0); PG8_LDB(B1, 1, 1); PG8_SCHED; PG8_LDA(At, 1, 0); PG8_STAGE(PG8_SA(0, 1), a2 + hstepA, voffA);
            PG8_WAIT_V(8); PG8_WAIT_L(0); PG8_BAR; PG8_MMA(0, 0, At, B0); PG8_MMA(0, 1, At, B1); PG8_BAR; PG8_SCHED;
            PG8_LDA(At, 1, 1); PG8_STAGE(PG8_SB(1, 0), b3, voffB); PG8_STAGE(PG8_SB(1, 1), b3 + hstepB, voffB); PG8_STAGE(PG8_SA(1, 0), a3, voffA);
            PG8_WAIT_V(8); PG8_WAIT_L(0); PG8_BAR; PG8_MMA(1, 0, At, B0); PG8_MMA(1, 1, At, B1); PG8_BAR; PG8_SCHED;
            } else {
            PG8_LDB(B0, 0, 0); PG8_SCHED; PG8_LDA(At, 0, 0); PG8_STAGE(PG8_SA(1, 1), a1 + hstepA, voffA);
            PG8_WAIT_L(8); PG8_BAR; PG8_WAIT_L(0); PG8_MMA(0, 0, At, B0); PG8_BAR; PG8_SCHED;
            PG8_LDB(B1, 0, 1); PG8_STAGE(PG8_SB(0, 0), b2, voffB);
            PG8_BAR; PG8_WAIT_L(0); PG8_MMA(0, 1, At, B1); PG8_BAR;
            PG8_LDA(At, 0, 1); PG8_STAGE(PG8_SA(0, 0), a2, voffA);
            PG8_BAR; PG8_WAIT_L(0); PG8_MMA(1, 0, At, B0); PG8_BAR; PG8_SCHED;
            PG8_STAGE(PG8_SB(0, 1), b2 + hstepB, voffB);
            PG8_WAIT_V(6); PG8_BAR; PG8_MMA(1, 1, At, B1); PG8_BAR;
            PG8_LDB(B0, 1, 0); PG8_SCHED; PG8_LDA(At, 1, 0); PG8_STAGE(PG8_SA(0, 1), a2 + hstepA, voffA);
            PG8_WAIT_L(8); PG8_BAR; PG8_WAIT_L(0); PG8_MMA(0, 0, At, B0); PG8_BAR; PG8_SCHED;
            PG8_LDB(B1, 1, 1); PG8_STAGE(PG8_SB(1, 0), b3, voffB);
            PG8_BAR; PG8_WAIT_L(0); PG8_MMA(0, 1, At, B1); PG8_BAR;
            PG8_LDA(At, 1, 1); PG8_STAGE(PG8_SA(1, 0), a3, voffA);
            PG8_BAR; PG8_WAIT_L(0); PG8_MMA(1, 0, At, B0); PG8_BAR; PG8_SCHED;
            PG8_STAGE(PG8_SB(1, 1), b3 + hstepB, voffB);
            PG8_WAIT_V(6); PG8_BAR; PG8_MMA(1, 1, At, B1); PG8_BAR;
            }
        }
        if constexpr (ALIGN_EPI) { if (wr == 0) PG8_BAR; }
        if constexpr (!Epi::AFTER_DRAIN) { E(acc, cur, wr, wc, fr, fq); S.done(cur); }
        if (!has_next) break;
#pragma unroll
        for (int a = 0; a < 2; ++a)
#pragma unroll
            for (int b = 0; b < 2; ++b)
#pragma unroll
                for (int m = 0; m < 4; ++m)
#pragma unroll
                    for (int n = 0; n < 2; ++n) acc[a][b][m][n] = (f32x4){0.f, 0.f, 0.f, 0.f};
        cur = nxt; cA = nA; cB = nB; ++ui;
        if constexpr (ALIGN_EPI) { if (wr == 1) PG8_BAR; }
    }
    PG8_WAIT_V(0);
    if constexpr (!ALIGN_EPI) { if (wr == 0) PG8_BAR; }
    PG8_BAR;
    if constexpr (Epi::AFTER_DRAIN) { E.fused(acc, cur, wr, wc, fr, fq, lds, wid, lane); S.done(cur); }
#undef PG8_SA
#undef PG8_SB
#undef PG8_STAGE
#undef PG8_LDA
#undef PG8_LDB
#undef PG8_MMA
#undef PG8_WAIT_V
#undef PG8_WAIT_L
#undef PG8_BAR
#undef PG8_SCHED
}
}
constexpr int NWAVES = 8;
constexpr int BATCH = 2, SEQ = 16384, DM = 1024, DEPTH = 2, M = BATCH * SEQ, HD = 64;
constexpr int INW = 2188, INP = 2304, DFF = 2816, NGU = 2 * DFF;
constexpr int C_NQ = 0, C_KC = 256, C_VC = 320, C_KS = 384, C_VS = 448, C_KW = 512, C_VW = 576, C_SQ = 640, C_SK = 1152, C_SV = 1280, C_BQ = 1408, C_BK = 1664, C_BV = 1920, C_NG = 2176;
constexpr int NCP = 1024;
constexpr float RMS_EPS = 1e-6f;
constexpr int NPH = 1 + 11 * DEPTH;

constexpr size_t MiB = 1u << 20;
constexpr size_t WS_CTL = 0, CTL_ZERO_BYTES = 1 * MiB;
constexpr size_t WS_WIN = 2 * MiB, WS_WOUT = 11 * MiB, WS_WGU = 15 * MiB, WS_WDN = 37 * MiB, WS_W1 = 48 * MiB, WS_POSB = 52 * MiB, WS_KVC = 53 * MiB, WS_HIDC = 54 * MiB, WS_KVCB = 56 * MiB, WS_IDX = 58 * MiB;
constexpr size_t WS_XN = 64 * MiB, WS_PROJ = 128 * MiB, WS_HID = 128 * MiB, WS_IMP = 272 * MiB;
constexpr size_t WS_OCMP = 304 * MiB, WS_OSLC = 336 * MiB, WS_OWIN = 368 * MiB, WS_OSWA = 400 * MiB, WS_OSB = 464 * MiB, WS_F = 304 * MiB, WS_END = 496 * MiB;
static_assert(WS_WIN + (size_t)DEPTH * INP * DM * 2 <= WS_WOUT && WS_WOUT + (size_t)DEPTH * DM * DM * 2 <= WS_WGU && WS_WGU + (size_t)DEPTH * NGU * DM * 2 <= WS_WDN && WS_WDN + (size_t)DEPTH * DM * DFF * 2 <= WS_W1 && WS_W1 + (size_t)DEPTH * 2 * 256 * 2048 * 2 <= WS_POSB, "weights map");
static_assert(WS_PROJ + (size_t)M * INP * 2 <= WS_IMP && WS_HID + (size_t)M * DFF * 2 <= WS_OCMP && WS_IMP + (size_t)M * 256 * 4 <= WS_OCMP && WS_OSB + (size_t)M * 256 * 4 <= WS_END, "activation map");
constexpr int CW_BAR = 4096;

constexpr int RING_OFF = 0, RING_BYTES = 131072;
constexpr int LDSCTL_OFF = RING_BYTES, MISC_OFF = LDSCTL_OFF + 320;
constexpr int LDS_BYTES = 147456;

#define GAS __attribute__((address_space(1)))
#define LAS __attribute__((address_space(3)))
typedef unsigned short bf16;
typedef unsigned v4u __attribute__((ext_vector_type(4)));
typedef unsigned v2u __attribute__((ext_vector_type(2)));
typedef float f32x4 __attribute__((ext_vector_type(4)));
typedef GAS unsigned gu32;
#define LDS_WAIT() asm volatile("s_waitcnt lgkmcnt(0)" ::: "memory")
#define VM_WAIT() asm volatile("s_waitcnt vmcnt(0)" ::: "memory")
__device__ __forceinline__ unsigned f2bf(float f) { unsigned u = __builtin_bit_cast(unsigned, f); return (u + 0x7fffu + ((u >> 16) & 1u)) >> 16; }
__device__ __forceinline__ unsigned pk2(float lo, float hi) { return f2bf(lo) | (f2bf(hi) << 16); }
__device__ __forceinline__ float bf_lo(unsigned u) { return __uint_as_float(u << 16); }
__device__ __forceinline__ float bf_hi(unsigned u) { return __uint_as_float(u & 0xffff0000u); }
__device__ __forceinline__ float bf1(bf16 b) { return __uint_as_float(((unsigned)b) << 16); }

#define XB_TMO      128
#define XB_XCNT(j)  (256  + 64 * (j))
#define XB_XSUB(j)  (1280 + 64 * (j))
#define XB_XGEN(j)  (2304 + 64 * (j))
#define XB_TOP      3328
#define XB_TOPGEN   3392
#define XCD_BAR_WORDS 3456
#define XB_SPIN_CAP (1u << 18)
__device__ __forceinline__ unsigned xb_ld(unsigned* p)              { return __hip_atomic_load(p, __ATOMIC_RELAXED, __HIP_MEMORY_SCOPE_AGENT); }
__device__ __forceinline__ unsigned xb_add(unsigned* p, unsigned v) { return __hip_atomic_fetch_add(p, v, __ATOMIC_RELAXED, __HIP_MEMORY_SCOPE_AGENT); }
__device__ __forceinline__ unsigned xb_xcc_id() { return (unsigned)__builtin_amdgcn_s_getreg((3 << 11) | 20) & 0xFu; }
#define XB_SPIN(cond, bar) do { unsigned _sp = 0; while (cond) { __builtin_amdgcn_s_sleep(1); \
    if ((++_sp & 255u) == 0u) { if (xb_ld(&(bar)[XB_TMO])) break; if (_sp > XB_SPIN_CAP) { atomicAdd(&(bar)[XB_TMO], 1u); break; } } } } while (0)
struct XcdBarrier { unsigned* bar; unsigned x; volatile LAS unsigned* st; };
__device__ __forceinline__ XcdBarrier xcd_barrier_post(unsigned* bar, volatile LAS unsigned* st) {
    XcdBarrier b; b.bar = bar; b.x = xb_xcc_id(); b.st = st;
    if (threadIdx.x == 0) (void)xb_add(&bar[XB_XCNT(b.x)], 1u);
    return b;
}
__device__ __forceinline__ void xcd_barrier_complete(unsigned* bar, unsigned x, unsigned& nloc, unsigned& nx) {
    const unsigned G = gridDim.x * gridDim.y * gridDim.z;
    unsigned sum, cnt, mine, sp = 0u;
    for (;;) {
        sum = 0u; cnt = 0u; mine = 0u;
#pragma unroll
        for (unsigned j = 0; j < 16; ++j) { const unsigned c = xb_ld(&bar[XB_XCNT(j)]); sum += c; cnt += (c > 0u) ? 1u : 0u; mine = (j == x) ? c : mine; }
        if (sum == G) break;
        __builtin_amdgcn_s_sleep(1);
        if ((++sp & 255u) == 0u) { if (xb_ld(&bar[XB_TMO])) break; if (sp > XB_SPIN_CAP) { atomicAdd(&bar[XB_TMO], 1u); break; } }
    }
    nloc = mine > 0u ? mine : 1u; nx = cnt > 0u ? cnt : 1u;
}
__device__ __forceinline__ void xcd_barrier(const XcdBarrier& b) {
    asm volatile("s_waitcnt vmcnt(0)" ::: "memory");
    __syncthreads();
    if (threadIdx.x == 0) {
        unsigned* bar = b.bar;
        __builtin_amdgcn_s_waitcnt(0);
        unsigned nloc = b.st[0], nx = b.st[1];
        if (nloc == 0u) { xcd_barrier_complete(bar, b.x, nloc, nx); b.st[0] = nloc; b.st[1] = nx; }
        const unsigned old = xb_add(&bar[XB_XSUB(b.x)], 1u);
        const unsigned gen = old / nloc;
        if (old + 1u == (gen + 1u) * nloc) {
            __builtin_amdgcn_fence(__ATOMIC_RELEASE, "agent");
            asm volatile("s_waitcnt vmcnt(0)" ::: "memory");
            const unsigned og = xb_add(&bar[XB_TOP], 1u);
            const unsigned tg = og / nx;
            if (og + 1u == (tg + 1u) * nx) xb_add(&bar[XB_TOPGEN], 1u);
            else XB_SPIN(xb_ld(&bar[XB_TOPGEN]) == tg, bar);
            __builtin_amdgcn_fence(__ATOMIC_ACQUIRE, "agent");
            xb_add(&bar[XB_XGEN(b.x)], 1u);
            asm volatile("s_waitcnt vmcnt(0)" ::: "memory");
        } else {
            XB_SPIN(xb_ld(&bar[XB_XGEN(b.x)]) == gen, bar);
            __builtin_amdgcn_fence(__ATOMIC_ACQUIRE, "agent");
            asm volatile("s_waitcnt vmcnt(0)" ::: "memory");
        }
    }
    __syncthreads();
}

__device__ __forceinline__ float wave_sum(float v) {
#pragma unroll
    for (int o = 1; o < 64; o <<= 1) v += __shfl_xor(v, o);
    return v;
}
__device__ __forceinline__ int t5_bucket(int n) {
    n = n < 0 ? 0 : n;
    if (n < 16) return n;
    const int e = 31 - __clz(n);
    const unsigned nn = (unsigned)n * (unsigned)n;
    const int f = 2 * e + ((nn >> (2 * e + 1)) ? 1 : 0);
    const int b = f + 8;
    return b > 31 ? 31 : b;
}
__device__ __forceinline__ void load_row_bf16(float (&q)[64], const bf16* p) {
    const v4u* p4 = (const v4u*)p;
#pragma unroll
    for (int c = 0; c < 8; ++c) { const v4u w = p4[c];
        q[8 * c + 0] = bf_lo(w.x); q[8 * c + 1] = bf_hi(w.x); q[8 * c + 2] = bf_lo(w.y); q[8 * c + 3] = bf_hi(w.y);
        q[8 * c + 4] = bf_lo(w.z); q[8 * c + 5] = bf_hi(w.z); q[8 * c + 6] = bf_lo(w.w); q[8 * c + 7] = bf_hi(w.w); }
}
__device__ __forceinline__ float dot64(const float (&q)[64], const bf16* p) {
    const v4u* p4 = (const v4u*)p; float s0 = 0.f, s1 = 0.f;
#pragma unroll
    for (int c = 0; c < 8; ++c) { const v4u w = p4[c];
        s0 = fmaf(q[8 * c + 0], bf_lo(w.x), s0); s1 = fmaf(q[8 * c + 1], bf_hi(w.x), s1); s0 = fmaf(q[8 * c + 2], bf_lo(w.y), s0); s1 = fmaf(q[8 * c + 3], bf_hi(w.y), s1);
        s0 = fmaf(q[8 * c + 4], bf_lo(w.z), s0); s1 = fmaf(q[8 * c + 5], bf_hi(w.z), s1); s0 = fmaf(q[8 * c + 6], bf_lo(w.w), s0); s1 = fmaf(q[8 * c + 7], bf_hi(w.w), s1); }
    return s0 + s1;
}
__device__ __forceinline__ void axpy64(float (&acc)[64], float p, const bf16* vp) {
    const v4u* p4 = (const v4u*)vp;
#pragma unroll
    for (int c = 0; c < 8; ++c) { const v4u w = p4[c];
        acc[8 * c + 0] = fmaf(p, bf_lo(w.x), acc[8 * c + 0]); acc[8 * c + 1] = fmaf(p, bf_hi(w.x), acc[8 * c + 1]); acc[8 * c + 2] = fmaf(p, bf_lo(w.y), acc[8 * c + 2]); acc[8 * c + 3] = fmaf(p, bf_hi(w.y), acc[8 * c + 3]);
        acc[8 * c + 4] = fmaf(p, bf_lo(w.z), acc[8 * c + 4]); acc[8 * c + 5] = fmaf(p, bf_hi(w.z), acc[8 * c + 5]); acc[8 * c + 6] = fmaf(p, bf_lo(w.w), acc[8 * c + 6]); acc[8 * c + 7] = fmaf(p, bf_hi(w.w), acc[8 * c + 7]); }
}
__device__ __forceinline__ float dot64f(const float (&q)[64], const float* p) {
    const f32x4* p4 = (const f32x4*)p; float s0 = 0.f, s1 = 0.f;
#pragma unroll
    for (int c = 0; c < 16; ++c) { const f32x4 w = p4[c]; s0 = fmaf(q[4 * c + 0], w.x, s0); s1 = fmaf(q[4 * c + 1], w.y, s1); s0 = fmaf(q[4 * c + 2], w.z, s0); s1 = fmaf(q[4 * c + 3], w.w, s1); }
    return s0 + s1;
}
__device__ __forceinline__ void axpy64f(float (&acc)[64], float p, const float* vp) {
    const f32x4* p4 = (const f32x4*)vp;
#pragma unroll
    for (int c = 0; c < 16; ++c) { const f32x4 w = p4[c]; acc[4 * c + 0] = fmaf(p, w.x, acc[4 * c + 0]); acc[4 * c + 1] = fmaf(p, w.y, acc[4 * c + 1]); acc[4 * c + 2] = fmaf(p, w.z, acc[4 * c + 2]); acc[4 * c + 3] = fmaf(p, w.w, acc[4 * c + 3]); }
}
__device__ __forceinline__ void store_row_f32(float* o, const float (&acc)[64], float sc) {
    f32x4* o4 = (f32x4*)o;
#pragma unroll
    for (int c = 0; c < 16; ++c) o4[c] = (f32x4){acc[4 * c] * sc, acc[4 * c + 1] * sc, acc[4 * c + 2] * sc, acc[4 * c + 3] * sc};
}
__device__ __forceinline__ void rms_row_to_bf16(const float* xrow, const float* g, bf16* orow, int lane) {
    const f32x4* xr = (const f32x4*)xrow + lane; f32x4 v[4]; float s = 0.f;
#pragma unroll
    for (int j = 0; j < 4; ++j) { v[j] = xr[64 * j]; s += (v[j].x * v[j].x + v[j].y * v[j].y) + (v[j].z * v[j].z + v[j].w * v[j].w); }
    const float rstd = rsqrtf(wave_sum(s) * (1.f / DM) + RMS_EPS);
    const f32x4* gr = (const f32x4*)g + lane; v2u* o8 = (v2u*)orow + lane;
#pragma unroll
    for (int j = 0; j < 4; ++j) { const f32x4 gv = gr[64 * j]; v2u w; w.x = pk2(v[j].x * rstd * gv.x, v[j].y * rstd * gv.y); w.y = pk2(v[j].z * rstd * gv.z, v[j].w * rstd * gv.w); o8[64 * j] = w; }
}

struct Args { const float* in[17]; float* out; unsigned char* ws; int ph_lo, ph_hi, li, pad; };
enum { I_X = 0, I_RELB, I_LNAP, I_WIN, I_POS, I_W1, I_B1, I_W2, I_SINK, I_GRPG, I_WOUT, I_LNAPOST, I_LNFP, I_WG, I_WU, I_WD, I_LNFPOST };

__device__ __forceinline__ void p0_prologue(const Args& a, LAS unsigned char* lds, int tid, int lane, int wave) {
    unsigned char* ws = a.ws;
    LAS float* tile = (LAS float*)lds;
    for (int it = blockIdx.x; it < 6400; it += gridDim.x) {
        const int l = it / 3200; int r = it % 3200;
        const int nl = tid & 63;
        const float* W; int ldw, Kd, kt, nt, col; bf16* dst;
        if (r < 576) { kt = r / 36; nt = r % 36; const int n = nt * 64 + nl; W = a.in[I_WIN] + (size_t)l * DM * INW; ldw = INW; Kd = DM;
            col = n < 640 ? n : (n < 2176 ? n + 12 : (n < 2188 ? n - 2176 + 640 : -1)); dst = (bf16*)(ws + WS_WIN) + (size_t)l * INP * DM; }
        else if (r < 832) { r -= 576; kt = r / 16; nt = r % 16; W = a.in[I_WOUT] + (size_t)l * DM * DM; ldw = DM; Kd = DM; col = nt * 64 + nl; dst = (bf16*)(ws + WS_WOUT) + (size_t)l * DM * DM; }
        else if (r < 2240) { r -= 832; kt = r / 88; nt = r % 88; const int n = nt * 64 + nl, t = n >> 7; W = ((t & 1) ? a.in[I_WU] : a.in[I_WG]) + (size_t)l * DM * DFF; ldw = DFF; Kd = DM;
            col = (t >> 1) * 128 + (n & 127); dst = (bf16*)(ws + WS_WGU) + (size_t)l * NGU * DM; }
        else if (r < 2944) { r -= 2240; kt = r / 16; nt = r % 16; W = a.in[I_WD] + (size_t)l * DFF * DM; ldw = DM; Kd = DFF; col = nt * 64 + nl; dst = (bf16*)(ws + WS_WDN) + (size_t)l * DM * DFF; }
        else { r -= 2944; const int kv = r / 128; r %= 128; kt = r / 4; nt = r % 4; W = a.in[I_W1] + (size_t)(l * 2 + kv) * 2048 * 256; ldw = 256; Kd = 2048; col = nt * 64 + nl;
            dst = (bf16*)(ws + WS_W1) + (size_t)(l * 2 + kv) * 256 * 2048; }
#pragma unroll
        for (int i = 0; i < 8; ++i) { const int k = i * 8 + (tid >> 6); tile[k * 65 + nl] = col >= 0 ? W[(size_t)(kt * 64 + k) * ldw + col] : 0.f; }
        __syncthreads();
        { const int rr = tid >> 3, c = tid & 7; const LAS float* s = tile + (8 * c) * 65 + rr;
          v4u o; o.x = pk2(s[0 * 65], s[1 * 65]); o.y = pk2(s[2 * 65], s[3 * 65]); o.z = pk2(s[4 * 65], s[5 * 65]); o.w = pk2(s[6 * 65], s[7 * 65]);
          *(v4u*)(dst + (size_t)(nt * 64 + rr) * Kd + kt * 64 + 8 * c) = o; }
        __syncthreads();
    }
    const int gw = blockIdx.x * NWAVES + wave, NGW = gridDim.x * NWAVES;
    for (int o = gw; o < DEPTH * 2 * 256; o += NGW) { const int lk = o >> 8, n = o & 255; float s = 0.f;
        const float* pos = a.in[I_POS] + (size_t)lk * 2048; const float* w1 = a.in[I_W1] + (size_t)lk * 2048 * 256 + n;
#pragma unroll 8
        for (int i = 0; i < 32; ++i) { const int k = lane + 64 * i; s = fmaf(pos[k], w1[(size_t)k * 256], s); }
        s = wave_sum(s);
        if (lane == 0) ((float*)(ws + WS_POSB))[o] = s + a.in[I_B1][o]; }
    for (int m = gw; m < M; m += NGW) rms_row_to_bf16(a.in[I_X] + (size_t)m * DM, a.in[I_LNAP], (bf16*)(ws + WS_XN) + (size_t)m * DM, lane);
}

__device__ __forceinline__ void p_compress2(const Args& a, int l, int tid) {
    const bf16* hid = (const bf16*)(a.ws + WS_HIDC); float* kvc = (float*)(a.ws + WS_KVC);
    const int NT = gridDim.x * NWAVES * 64;
    for (int idx = blockIdx.x * NWAVES * 64 + tid; idx < 2 * 2048 * 64; idx += NT) {
        const int d = idx & 63, m = (idx >> 6) & 2047, kv = idx >> 17;
        const float* w2 = a.in[I_W2] + (size_t)(l * 2 + kv) * 256 * 64 + d; const bf16* hr = hid + ((size_t)kv * 2048 + m) * 256; float s = 0.f;
#pragma unroll 8
        for (int n = 0; n < 256; ++n) s = fmaf(bf1(hr[n]), w2[n * 64], s);
        if ((m & (NCP - 1)) == NCP - 1) s = 0.f;
        kvc[idx] = s; ((bf16*)(a.ws + WS_KVCB))[idx] = (bf16)f2bf(s);
    }
}

namespace fa {
typedef short bf16x8 __attribute__((ext_vector_type(8)));
typedef float f32x16 __attribute__((ext_vector_type(16)));
typedef short s16x4 __attribute__((ext_vector_type(4)));
constexpr int KP = 144;
constexpr int L_K = 0, L_V = 64 * KP, L_TAB = L_V + 8192;
constexpr float LOG2E = 1.4426950408889634f;
constexpr float C2 = 0.125f * LOG2E;
__device__ __forceinline__ int crow(int r, int hi) { return (r & 3) + 8 * (r >> 2) + 4 * hi; }
__device__ __forceinline__ unsigned cvtpk(float lo, float hi) { unsigned r; asm volatile("v_cvt_pk_bf16_f32 %0, %1, %2" : "=v"(r) : "v"(lo), "v"(hi)); return r; }
__device__ __forceinline__ float swap32(float v) { const unsigned u = __float_as_uint(v); auto rr = __builtin_amdgcn_permlane32_swap(u, u, false, false); return __uint_as_float(rr[0] == u ? rr[1] : rr[0]); }
struct Stage { v4u k, v; };
__device__ __forceinline__ void stage_load(Stage& s, const bf16* Kg, const bf16* Vg, size_t ldk, size_t ldv, int tid) {
    const int key = tid >> 3, ch = tid & 7;
    s.k = *(const v4u*)(Kg + (size_t)key * ldk + ch * 8); s.v = *(const v4u*)(Vg + (size_t)key * ldv + ch * 8);
}
__device__ __forceinline__ void stage_store(const Stage& s, LAS unsigned char* lds, int tid) {
    const int key = tid >> 3, ch = tid & 7;
    *(LAS v4u*)(lds + L_K + key * KP + ch * 16) = s.k;
    *(LAS v4u*)(lds + L_V + (ch >> 2) * 4096 + key * 64 + (ch & 3) * 16) = s.v;
}
__device__ __forceinline__ void load_q(bf16x8 (&qf)[4], const bf16* qrow, int hi) {
#pragma unroll
    for (int s = 0; s < 4; ++s) qf[s] = *(const bf16x8*)(qrow + 16 * s + 8 * hi);
}
__device__ __forceinline__ void qk_tile(f32x16& p0, f32x16& p1, const LAS unsigned char* lds, const bf16x8 (&qf)[4], int lane) {
    const LAS unsigned char* kb = lds + L_K + (lane & 31) * KP + (lane >> 5) * 16;
#pragma unroll
    for (int r = 0; r < 16; ++r) { p0[r] = 0.f; p1[r] = 0.f; }
#pragma unroll
    for (int s = 0; s < 4; ++s) {
        const bf16x8 a0 = *(const LAS bf16x8*)(kb + s * 32), a1 = *(const LAS bf16x8*)(kb + 32 * KP + s * 32);
        p0 = __builtin_amdgcn_mfma_f32_32x32x16_bf16(a0, qf[s], p0, 0, 0, 0); p1 = __builtin_amdgcn_mfma_f32_32x32x16_bf16(a1, qf[s], p1, 0, 0, 0);
    }
}
__device__ __forceinline__ s16x4 vtr(const LAS unsigned char* p) { return __builtin_bit_cast(s16x4, __builtin_amdgcn_ds_read_tr16_b64_v4i16((LAS s16x4*)p)); }
__device__ __forceinline__ void pv_tile(f32x16& o0, f32x16& o1, const LAS unsigned char* lds, const f32x16& p0, const f32x16& p1, int lane) {
    const int hi = lane >> 5;
    const LAS unsigned char* vb = lds + L_V + ((lane & 15) >> 2) * 64 + (((lane >> 4) & 1) * 16 + (lane & 3) * 4) * 2 + (4 * hi) * 64;
#pragma unroll
    for (int ks = 0; ks < 4; ++ks) {
        const f32x16& p = ks < 2 ? p0 : p1; const int b = 8 * (ks & 1);
        v4u pw; pw.x = cvtpk(p[b + 0], p[b + 1]); pw.y = cvtpk(p[b + 2], p[b + 3]); pw.z = cvtpk(p[b + 4], p[b + 5]); pw.w = cvtpk(p[b + 6], p[b + 7]);
        const bf16x8 pb = __builtin_bit_cast(bf16x8, pw);
#pragma unroll
        for (int dt = 0; dt < 2; ++dt) {
            const s16x4 lo = vtr(vb + dt * 4096 + (16 * ks) * 64), hh = vtr(vb + dt * 4096 + (16 * ks + 8) * 64);
            const bf16x8 a = (bf16x8){lo[0], lo[1], lo[2], lo[3], hh[0], hh[1], hh[2], hh[3]};
            if (dt == 0) o0 = __builtin_amdgcn_mfma_f32_32x32x16_bf16(a, pb, o0, 0, 0, 0); else o1 = __builtin_amdgcn_mfma_f32_32x32x16_bf16(a, pb, o1, 0, 0, 0);
        }
    }
}
__device__ __forceinline__ void softmax_step(f32x16& p0, f32x16& p1, float& m, float& l, f32x16& o0, f32x16& o1) {
    float tm = fmaxf(p0[0], p1[0]);
#pragma unroll
    for (int r = 1; r < 16; ++r) tm = fmaxf(tm, fmaxf(p0[r], p1[r]));
    tm = fmaxf(tm, swap32(tm));
    if (__any(tm > m)) { const float mn = fmaxf(m, tm), sc = __builtin_amdgcn_exp2f(m - mn); m = mn; l *= sc;
#pragma unroll
        for (int r = 0; r < 16; ++r) { o0[r] *= sc; o1[r] *= sc; } }
    float s = 0.f;
#pragma unroll
    for (int r = 0; r < 16; ++r) { p0[r] = __builtin_amdgcn_exp2f(p0[r] - m); p1[r] = __builtin_amdgcn_exp2f(p1[r] - m); s += p0[r] + p1[r]; }
    l += s;
}
__device__ __forceinline__ void store_ot(float* orow, const f32x16& o0, const f32x16& o1, float sc, int hi) {
#pragma unroll
    for (int g = 0; g < 4; ++g) {
        *(f32x4*)(orow + 8 * g + 4 * hi) = (f32x4){o0[4 * g] * sc, o0[4 * g + 1] * sc, o0[4 * g + 2] * sc, o0[4 * g + 3] * sc};
        *(f32x4*)(orow + 32 + 8 * g + 4 * hi) = (f32x4){o1[4 * g] * sc, o1[4 * g + 1] * sc, o1[4 * g + 2] * sc, o1[4 * g + 3] * sc};
    }
}

template <int WIN, bool SINK>
__device__ __forceinline__ void band_unit(LAS unsigned char* lds, const bf16* PROJ, const float* relb, int tok0, int cq, int ck, int cv, int bh0, const float* sinks, float* out, int old, int ocol0, int tid, int lane, int wave) {
    constexpr int TW = WIN + 128;
    LAS float* bd = (LAS float*)(lds + L_TAB);
    __syncthreads();
    for (int i = tid; i < 4 * TW; i += NWAVES * 64) { const int hl = i / TW, dist = i % TW - 64;
        bd[i] = (dist < 0 || dist >= WIN) ? -INFINITY : relb[t5_bucket(dist) * 12 + bh0 + hl] * LOG2E; }
    const int hl = wave >> 1, hi = lane >> 5, q32 = lane & 31;
    const int t0 = tok0 & (SEQ - 1); const size_t rb = (size_t)(tok0 - t0);
    const int tq = tok0 + 32 * (wave & 1) + q32, t = tq & (SEQ - 1);
    bf16x8 qf[4]; load_q(qf, PROJ + (size_t)tq * INP + cq + hl * 64, hi);
    f32x16 o0, o1;
#pragma unroll
    for (int r = 0; r < 16; ++r) { o0[r] = 0.f; o1[r] = 0.f; }
    float m = -1e30f, l = 0.f;
    if (SINK) { m = sinks[hl] * LOG2E; l = hi == 0 ? 1.f : 0.f; }
    const int kt_hi = t0 >> 6, kt_lo = (t0 - WIN > 0 ? t0 - WIN : 0) >> 6;
    Stage st; stage_load(st, PROJ + (rb + (size_t)kt_hi * 64) * INP + ck, PROJ + (rb + (size_t)kt_hi * 64) * INP + cv, INP, INP, tid);
    const LAS float* bdh = bd + hl * TW;
    for (int kt = kt_hi; kt >= kt_lo; --kt) {
        __syncthreads();
        stage_store(st, lds, tid);
        __syncthreads();
        if (kt > kt_lo) stage_load(st, PROJ + (rb + (size_t)(kt - 1) * 64) * INP + ck, PROJ + (rb + (size_t)(kt - 1) * 64) * INP + cv, INP, INP, tid);
        f32x16 p0, p1; qk_tile(p0, p1, lds, qf, lane);
        const LAS float* bp = bdh + (t - kt * 64 + 64 - 63);
#pragma unroll
        for (int r = 0; r < 16; ++r) { p0[r] = fmaf(p0[r], C2, bp[63 - crow(r, hi)]); p1[r] = fmaf(p1[r], C2, bp[63 - 32 - crow(r, hi)]); }
        softmax_step(p0, p1, m, l, o0, o1);
        pv_tile(o0, o1, lds, p0, p1, lane);
    }
    l += swap32(l);
    store_ot(out + (size_t)tq * old + ocol0 + hl * 64, o0, o1, 1.f / l, hi);
}

__device__ __forceinline__ void stat_step(const f32x16& p0, const f32x16& p1, float& m, float& l) {
    float tm = fmaxf(p0[0], p1[0]);
#pragma unroll
    for (int r = 1; r < 16; ++r) tm = fmaxf(tm, fmaxf(p0[r], p1[r]));
    tm = fmaxf(tm, swap32(tm));
    const float mn = fmaxf(m, tm); l *= __builtin_amdgcn_exp2f(m - mn); m = mn;
    float s = 0.f;
#pragma unroll
    for (int r = 0; r < 16; ++r) s += __builtin_amdgcn_exp2f(p0[r] - m) + __builtin_amdgcn_exp2f(p1[r] - m);
    l += s;
}
constexpr int L_IMP = L_TAB + 1024, IMP_P = 257;
constexpr float IMP_SCALE = 134217728.f;
__device__ __forceinline__ void cmp_unit(LAS unsigned char* lds, const bf16* PROJ, const bf16* KCB, const bf16* VCB, const float* relb, int tok0, float* OCMP, int* IDX, int tid, int lane, int wave) {
    LAS float* tabl = (LAS float*)(lds + L_TAB); LAS unsigned* imp = (LAS unsigned*)(lds + L_IMP);
    __syncthreads();
    if (tid < 128) tabl[tid] = relb[(tid & 31) * 12 + (tid >> 5)] * LOG2E;
    for (int i = tid; i < 64 * IMP_P; i += NWAVES * 64) imp[i] = 0u;
    const int hl = wave >> 1, hi = lane >> 5, q32 = lane & 31;
    const int t0 = tok0 & (SEQ - 1), b = tok0 >> 14;
    const int tql = 32 * (wave & 1) + q32, tq = tok0 + tql, t = tq & (SEQ - 1);
    bf16x8 qf[4]; load_q(qf, PROJ + (size_t)tq * INP + C_NQ + hl * 64, hi);
    const int nc_unit = ((t0 + 63 - 31) >> 4) + 1, ntile = (nc_unit + 63) >> 6;
    const bf16* kcb = KCB + (size_t)b * NCP * 64; const bf16* vcb = VCB + (size_t)b * NCP * 64;
    const LAS float* th = tabl + hl * 32;
    float m = -1e30f, l = 0.f;
    f32x16 o0, o1;
#pragma unroll
    for (int r = 0; r < 16; ++r) { o0[r] = 0.f; o1[r] = 0.f; }
    float inv = 0.f;
    for (int pass = 0; pass < 2; ++pass) {
        Stage st; stage_load(st, kcb, vcb, 64, 64, tid);
        for (int ct = 0; ct < ntile; ++ct) {
            __syncthreads();
            stage_store(st, lds, tid);
            __syncthreads();
            if (ct + 1 < ntile) stage_load(st, kcb + (size_t)(ct + 1) * 64 * 64, vcb + (size_t)(ct + 1) * 64 * 64, 64, 64, tid);
            f32x16 p0, p1; qk_tile(p0, p1, lds, qf, lane);
            const int dbase = t - 31 - 1024 * ct;
#pragma unroll
            for (int r = 0; r < 16; ++r) { const int d0 = dbase - 16 * crow(r, hi), d1 = d0 - 512;
                p0[r] = d0 >= 0 ? fmaf(p0[r], C2, th[t5_bucket(d0)]) : -INFINITY; p1[r] = d1 >= 0 ? fmaf(p1[r], C2, th[t5_bucket(d1)]) : -INFINITY; }
            if (pass == 0) { stat_step(p0, p1, m, l); }
            else {
#pragma unroll
                for (int r = 0; r < 16; ++r) { p0[r] = __builtin_amdgcn_exp2f(p0[r] - m) * inv; p1[r] = __builtin_amdgcn_exp2f(p1[r] - m) * inv; }
                pv_tile(o0, o1, lds, p0, p1, lane);
                LAS unsigned* ir = imp + tql * IMP_P + 16 * ct + hi;
#pragma unroll
                for (int g = 0; g < 4; ++g) {
                    { const float A = (p0[4 * g] + p0[4 * g + 1]) + (p0[4 * g + 2] + 0.5f * p0[4 * g + 3]), Cc = 0.5f * p0[4 * g + 3];
                      __hip_atomic_fetch_add(ir + 2 * g, (unsigned)(A * IMP_SCALE + 0.5f), __ATOMIC_RELAXED, __HIP_MEMORY_SCOPE_WORKGROUP); __hip_atomic_fetch_add(ir + 2 * g + 1, (unsigned)(Cc * IMP_SCALE + 0.5f), __ATOMIC_RELAXED, __HIP_MEMORY_SCOPE_WORKGROUP); }
                    { const float A = (p1[4 * g] + p1[4 * g + 1]) + (p1[4 * g + 2] + 0.5f * p1[4 * g + 3]), Cc = 0.5f * p1[4 * g + 3];
                      __hip_atomic_fetch_add(ir + 8 + 2 * g, (unsigned)(A * IMP_SCALE + 0.5f), __ATOMIC_RELAXED, __HIP_MEMORY_SCOPE_WORKGROUP); __hip_atomic_fetch_add(ir + 8 + 2 * g + 1, (unsigned)(Cc * IMP_SCALE + 0.5f), __ATOMIC_RELAXED, __HIP_MEMORY_SCOPE_WORKGROUP); }
                }
            }
        }
        if (pass == 0) { const float lt = l + swap32(l); inv = lt > 0.f ? 1.f / lt : 0.f; }
    }
    store_ot(OCMP + (size_t)tq * 256 + hl * 64, o0, o1, 1.f, hi);
    __syncthreads();
    for (int k = 0; k < 8; ++k) {
        const int tl = wave * 8 + k, tt = t0 + tl, cur = tt >> 6;
        int my = -1;
        if (cur <= 15) { my = lane <= cur ? lane : -1; }
        else {
            int v[4];
#pragma unroll
            for (int i = 0; i < 4; ++i) { const int j = lane + 64 * i; v[i] = (j >= 1 && j <= cur - 2) ? (int)imp[tl * IMP_P + j] : -1; }
            if (lane == 0) my = 0; else if (lane == 1) my = cur - 1; else if (lane == 2) my = cur;
            for (int r = 0; r < 13; ++r) {
                int bv = v[0], bj = lane;
#pragma unroll
                for (int i = 1; i < 4; ++i) if (v[i] > bv) { bv = v[i]; bj = lane + 64 * i; }
#pragma unroll
                for (int o = 1; o < 64; o <<= 1) { const int ov = __shfl_xor(bv, o), oj = __shfl_xor(bj, o); if (ov > bv || (ov == bv && oj < bj)) { bv = ov; bj = oj; } }
                if (lane == 3 + r) my = bj;
#pragma unroll
                for (int i = 0; i < 4; ++i) if (lane + 64 * i == bj) v[i] = -1;
            }
        }
        if (lane < 16) IDX[(size_t)(tok0 + tl) * 16 + lane] = my;
    }
}

__device__ __forceinline__ void sb_unit(LAS unsigned char* lds, const bf16* PROJ, int tok0, int h, float* OSB, int tid, int lane, int wave) {
    LAS int* flags = (LAS int*)(lds + L_TAB);
    __syncthreads();
    if (tid < 8) flags[tid] = 0;
    const int hi = lane >> 5, q32 = lane & 31;
    const int t0 = tok0 & (SEQ - 1); const size_t rb = (size_t)(tok0 - t0);
    const int tq = tok0 + 32 * wave + q32, t = tq & (SEQ - 1);
    bf16x8 qf[4]; load_q(qf, PROJ + (size_t)tq * INP + C_BQ + h * 64, hi);
    f32x16 o0, o1;
#pragma unroll
    for (int r = 0; r < 16; ++r) { o0[r] = 0.f; o1[r] = 0.f; }
    float carry = 0.f; bool done = false;
    const int kt_hi = (t0 >> 6) + 3, kt_w = (t0 + 32 * wave + 31) >> 6;
    const int ck = C_BK + h * 64, cv = C_BV + h * 64;
    Stage st; stage_load(st, PROJ + (rb + (size_t)kt_hi * 64) * INP + ck, PROJ + (rb + (size_t)kt_hi * 64) * INP + cv, INP, INP, tid);
    for (int kt = kt_hi; kt >= 0; --kt) {
        __syncthreads();
        stage_store(st, lds, tid);
        if (lane == 0) flags[wave] = done ? 1 : 0;
        __syncthreads();
        { int alld = 1;
#pragma unroll
          for (int w = 0; w < 8; ++w) alld &= flags[w];
          if (alld) break; }
        if (kt > 0) stage_load(st, PROJ + (rb + (size_t)(kt - 1) * 64) * INP + ck, PROJ + (rb + (size_t)(kt - 1) * 64) * INP + cv, INP, INP, tid);
        if (!done && kt <= kt_w) {
            f32x16 p0, p1; qk_tile(p0, p1, lds, qf, lane);
            const int kb = t - kt * 64;
#pragma unroll
            for (int half = 1; half >= 0; --half) {
                f32x16& p = half ? p1 : p0; float T[4], U[4];
                float ln[16];
#pragma unroll
                for (int r = 0; r < 16; ++r) { const float z = p[r] * 0.125f; const bool valid = (32 * half + crow(r, hi)) < kb;
                    const float sp = fmaxf(z, 0.f) + __logf(1.f + __expf(-fabsf(z)));
                    ln[r] = valid ? -sp : 0.f; p[r] = valid ? z - sp : -INFINITY; }
#pragma unroll
                for (int g = 0; g < 4; ++g) { T[g] = (ln[4 * g] + ln[4 * g + 1]) + (ln[4 * g + 2] + ln[4 * g + 3]); U[g] = swap32(T[g]); }
                float suf = carry;
#pragma unroll
                for (int g = 3; g >= 0; --g) {
                    float off = suf + (hi == 0 ? U[g] : 0.f);
                    const float l3 = off, l2 = l3 + ln[4 * g + 3], l1 = l2 + ln[4 * g + 2], l0 = l1 + ln[4 * g + 1];
                    p[4 * g + 3] = __expf(p[4 * g + 3] + l3); p[4 * g + 2] = __expf(p[4 * g + 2] + l2); p[4 * g + 1] = __expf(p[4 * g + 1] + l1); p[4 * g] = __expf(p[4 * g] + l0);
                    suf += T[g] + U[g];
                }
                carry = suf;
            }
            pv_tile(o0, o1, lds, p0, p1, lane);
            if (__all(carry < -104.f)) done = true;
        }
    }
    store_ot(OSB + (size_t)tq * 256 + h * 64, o0, o1, 1.f, hi);
}
}

__device__ __forceinline__ void cmp_item(const Args& a, int it, int lane, const LAS float* tab) {
    const bf16* PROJ = (const bf16*)(a.ws + WS_PROJ); const float* KC = (const float*)(a.ws + WS_KVC); const float* VC = KC + 2048 * 64;
    float* OCMP = (float*)(a.ws + WS_OCMP); float* IMP = (float*)(a.ws + WS_IMP);
    const int tl = lane >> 2, h = lane & 3, tok = it * 16 + tl, t = tok & (SEQ - 1);
    const int t0 = __builtin_amdgcn_readfirstlane((it * 16) & (SEQ - 1)), b = __builtin_amdgcn_readfirstlane((it * 16) >> 14);
    float q[64]; load_row_bf16(q, PROJ + (size_t)tok * INP + C_NQ + h * 64);
    const int nc_it = (t0 + 15 >= 31) ? ((t0 + 15 - 31) >> 4) + 1 : 0;
    const float* kcb = KC + (size_t)b * NCP * 64; const float* vcb = VC + (size_t)b * NCP * 64;
    float m = -INFINITY, lsum = 0.f;
    for (int c = 0; c < nc_it; ++c) {
        const int dist = t - (16 * c + 31);
        const float z = dot64f(q, kcb + (size_t)c * 64) * 0.125f + tab[t5_bucket(dist) * 12 + h];
        if (dist >= 0) { const float mn = fmaxf(m, z); lsum = lsum * __expf(m - mn) + __expf(z - mn); m = mn; }
    }
    const float inv_l = lsum > 0.f ? 1.f / lsum : 0.f;
    float acc[64];
#pragma unroll
    for (int d = 0; d < 64; ++d) acc[d] = 0.f;
    float cur = 0.f;
    for (int c = 0; c < nc_it; ++c) {
        const int dist = t - (16 * c + 31);
        const float z = dot64f(q, kcb + (size_t)c * 64) * 0.125f + tab[t5_bucket(dist) * 12 + h];
        const float p = dist >= 0 ? __expf(z - m) * inv_l : 0.f;
        axpy64f(acc, p, vcb + (size_t)c * 64);
        float ps = p + __shfl_xor(p, 1); ps += __shfl_xor(ps, 2);
        if ((c & 3) < 3) cur += ps; else { cur += 0.5f * ps; if (h == 0) IMP[(size_t)tok * 256 + (c >> 2)] = cur; cur = 0.5f * ps; }
    }
    store_row_f32(OCMP + (size_t)tok * 256 + h * 64, acc, 1.f);
}
template <int WIN> __device__ __forceinline__ void band_item(const bf16* PROJ, int tok0, int lane, int cq, int ck, int cv, const LAS float* tab, int bh, bool has_sink, float sink, float* out) {
    const int tok = tok0 + lane, t = tok & (SEQ - 1);
    const int t0 = __builtin_amdgcn_readfirstlane(tok0 & (SEQ - 1)); const size_t rb = (size_t)__builtin_amdgcn_readfirstlane(tok0 - (tok0 & (SEQ - 1)));
    float q[64]; load_row_bf16(q, PROJ + (size_t)tok * INP + cq);
    float acc[64];
#pragma unroll
    for (int d = 0; d < 64; ++d) acc[d] = 0.f;
    float m = has_sink ? sink : -INFINITY, lsum = has_sink ? 1.f : 0.f;
    const int s_lo = t0 - (WIN - 1) > 0 ? t0 - (WIN - 1) : 0;
    for (int s = s_lo; s <= t0 + 63; ++s) {
        const bf16* row = PROJ + (rb + (size_t)s) * INP;
        const int dist = t - s;
        float z = dot64(q, row + ck) * 0.125f;
        if (dist >= 0 && dist < WIN) {
            z += tab[t5_bucket(dist) * 12 + bh];
            if (z > m) { const float sc = __expf(m - z); lsum *= sc;
#pragma unroll
                for (int d = 0; d < 64; ++d) acc[d] *= sc;
                m = z; }
            const float p = __expf(z - m); lsum += p; axpy64(acc, p, row + cv);
        }
    }
    store_row_f32(out, acc, 1.f / lsum);
}
__device__ __forceinline__ void sb_item(const bf16* PROJ, int tok0, int lane, int h, float* out) {
    const int tok = tok0 + lane, t = tok & (SEQ - 1);
    const int t0 = __builtin_amdgcn_readfirstlane(tok0 & (SEQ - 1)); const size_t rb = (size_t)__builtin_amdgcn_readfirstlane(tok0 - (tok0 & (SEQ - 1)));
    float q[64]; load_row_bf16(q, PROJ + (size_t)tok * INP + C_BQ + h * 64);
    float acc[64];
#pragma unroll
    for (int d = 0; d < 64; ++d) acc[d] = 0.f;
    float later = 0.f;
    for (int s = t0 + 62; s >= 0; --s) {
        const bf16* row = PROJ + (rb + (size_t)s) * INP;
        const float z = dot64(q, row + C_BK + h * 64) * 0.125f;
        if (s < t) {
            const float sp = fmaxf(z, 0.f) + __logf(1.f + __expf(-fabsf(z)));
            const float aw = __expf(z - sp + later);
            axpy64(acc, aw, row + C_BV + h * 64);
            later -= sp;
        }
        if (s < t0 && __all(later < -104.f)) break;
    }
    store_row_f32(out, acc, 1.f);
}
__device__ __forceinline__ void p_attn_a(const Args& a, int l, LAS unsigned char* lds, int tid, int lane, int wave) {
    LAS float* tab = (LAS float*)lds;
    if (tid < 384) tab[tid] = a.in[I_RELB][tid];
    __syncthreads();
    const bf16* PROJ = (const bf16*)(a.ws + WS_PROJ);
    const int gw = blockIdx.x * NWAVES + wave, NGW = gridDim.x * NWAVES;
    for (int it = gw; it < M / 16; it += NGW) cmp_item(a, (M / 16 - 1) - it, lane, tab);
    for (int it = gw; it < (M / 64) * 4; it += NGW) { const int tile = it >> 2, h = it & 3;
        band_item<512>(PROJ, tile * 64, lane, C_NQ + h * 64, C_KW, C_VW, tab, h, false, 0.f, (float*)(a.ws + WS_OWIN) + (size_t)(tile * 64 + lane) * 256 + h * 64); }
    for (int it = gw; it < (M / 64) * 8; it += NGW) { const int tile = it >> 3, hq = it & 7;
        band_item<128>(PROJ, tile * 64, lane, C_SQ + hq * 64, C_SK + (hq >> 2) * 64, C_SV + (hq >> 2) * 64, tab, 4 + hq, true, a.in[I_SINK][l * 8 + hq], (float*)(a.ws + WS_OSWA) + (size_t)(tile * 64 + lane) * 512 + hq * 64); }
    for (int it = gw; it < (M / 64) * 4; it += NGW) { const int tile = it >> 2, h = it & 3;
        sb_item(PROJ, tile * 64, lane, h, (float*)(a.ws + WS_OSB) + (size_t)(tile * 64 + lane) * 256 + h * 64); }
}

__device__ __forceinline__ void p_attn_a_mfma(const Args& a, int l, LAS unsigned char* lds, int tid, int lane, int wave) {
    const bf16* PROJ = (const bf16*)(a.ws + WS_PROJ); const float* relb = a.in[I_RELB];
    const int G = gridDim.x;
    for (int u = blockIdx.x; u < M / 64; u += G) {
        const int tok0 = u < 256 ? u * 64 : SEQ + (255 - (u - 256)) * 64;
        fa::cmp_unit(lds, PROJ, (const bf16*)(a.ws + WS_KVCB), (const bf16*)(a.ws + WS_KVCB) + 2 * NCP * 64, relb, tok0, (float*)(a.ws + WS_OCMP), (int*)(a.ws + WS_IDX), tid, lane, wave); }
    for (int u = blockIdx.x; u < M / 64; u += G)
        fa::band_unit<512, false>(lds, PROJ, relb, u * 64, C_NQ, C_KW, C_VW, 0, nullptr, (float*)(a.ws + WS_OWIN), 256, 0, tid, lane, wave);
    for (int u = blockIdx.x; u < (M / 64) * 2; u += G) { const int g = u & 1;
        fa::band_unit<128, true>(lds, PROJ, relb, (u >> 1) * 64, C_SQ + g * 256, C_SK + g * 64, C_SV + g * 64, 4 + 4 * g, a.in[I_SINK] + l * 8 + 4 * g, (float*)(a.ws + WS_OSWA), 512, g * 256, tid, lane, wave); }
    for (int u = blockIdx.x; u < (M / 256) * 4; u += G)
        fa::sb_unit(lds, PROJ, (u >> 2) * 256, u & 3, (float*)(a.ws + WS_OSB), tid, lane, wave);
}
__device__ __forceinline__ void p_attn_b(const Args& a, LAS unsigned char* lds, int tid, int lane, int wave) {
    LAS float* tab = (LAS float*)lds; LAS int* idxL = (LAS int*)(lds + 2048) + wave * 256;
    if (tid < 384) tab[tid] = a.in[I_RELB][tid];
    __syncthreads();
    const bf16* PROJ = (const bf16*)(a.ws + WS_PROJ); const float* IMP = (const float*)(a.ws + WS_IMP); float* OSLC = (float*)(a.ws + WS_OSLC);
    const int gw = blockIdx.x * NWAVES + wave, NGW = gridDim.x * NWAVES;
    for (int it = gw; it < M / 16; it += NGW) {
#if USE_MFMA_A
        if (lane < 16) { for (int tl = 0; tl < 16; ++tl) idxL[tl * 16 + lane] = ((const int*)(a.ws + WS_IDX))[(size_t)(it * 16 + tl) * 16 + lane]; }
#else
        for (int tl = 0; tl < 16; ++tl) {
            const int tok = it * 16 + tl, t = tok & (SEQ - 1), cur = t >> 6;
            int my = -1;
            if (cur <= 15) { my = lane <= cur ? lane : -1; }
            else {
                float v[4];
#pragma unroll
                for (int i = 0; i < 4; ++i) { const int j = lane + 64 * i; v[i] = (j >= 1 && j <= cur - 2) ? IMP[(size_t)tok * 256 + j] : -INFINITY; }
                if (lane == 0) my = 0; else if (lane == 1) my = cur - 1; else if (lane == 2) my = cur;
                for (int r = 0; r < 13; ++r) {
                    float bv = v[0]; int bj = lane;
#pragma unroll
                    for (int i = 1; i < 4; ++i) if (v[i] > bv) { bv = v[i]; bj = lane + 64 * i; }
#pragma unroll
                    for (int o = 1; o < 64; o <<= 1) { const float ov = __shfl_xor(bv, o); const int oj = __shfl_xor(bj, o); if (ov > bv || (ov == bv && oj < bj)) { bv = ov; bj = oj; } }
                    if (lane == 3 + r) my = bj;
#pragma unroll
                    for (int i = 0; i < 4; ++i) if (lane + 64 * i == bj) v[i] = -INFINITY;
                }
            }
            if (lane < 16) idxL[tl * 16 + lane] = my;
        }
#endif
        LDS_WAIT();
        const int tl = lane >> 2, h = lane & 3, tok = it * 16 + tl, t = tok & (SEQ - 1);
        const size_t rb = (size_t)((it * 16) - ((it * 16) & (SEQ - 1)));
        float q[64]; load_row_bf16(q, PROJ + (size_t)tok * INP + C_NQ + h * 64);
        float acc[64];
#pragma unroll
        for (int d = 0; d < 64; ++d) acc[d] = 0.f;
        float m = -INFINITY, lsum = 0.f;
        for (int k = 0; k < 16; ++k) {
            const int blk = idxL[tl * 16 + k];
            for (int kk = 0; kk < 64; ++kk) {
                const int pos = blk * 64 + kk;
                if (blk >= 0 && pos <= t) {
                    const bf16* row = PROJ + (rb + (size_t)pos) * INP;
                    const float z = dot64(q, row + C_KS) * 0.125f + tab[t5_bucket(t - pos) * 12 + h];
                    if (z > m) { const float sc = __expf(m - z); lsum *= sc;
#pragma unroll
                        for (int d = 0; d < 64; ++d) acc[d] *= sc;
                        m = z; }
                    const float p = __expf(z - m); lsum += p; axpy64(acc, p, row + C_VS);
                }
            }
        }
        store_row_f32(OSLC + (size_t)tok * 256 + h * 64, acc, 1.f / lsum);
        LDS_WAIT();
    }
}
__device__ __forceinline__ void p_groupnorm(const Args& a, int l, int lane, int wave) {
    const bf16* PROJ = (const bf16*)(a.ws + WS_PROJ); bf16* MIX = (bf16*)(a.ws + WS_XN); const float* gg = a.in[I_GRPG] + (size_t)l * DM;
    const int gw = blockIdx.x * NWAVES + wave, NGW = gridDim.x * NWAVES;
    for (int tok = gw; tok < M; tok += NGW) {
        const int hd = lane >> 4; const bf16* gl = PROJ + (size_t)tok * INP + C_NG;
        const float g0 = 1.f / (1.f + __expf(-bf1(gl[hd]))), g1 = 1.f / (1.f + __expf(-bf1(gl[4 + hd]))), g2 = 1.f / (1.f + __expf(-bf1(gl[8 + hd])));
        const f32x4 oc = *((const f32x4*)((const float*)(a.ws + WS_OCMP) + (size_t)tok * 256) + lane), os = *((const f32x4*)((const float*)(a.ws + WS_OSLC) + (size_t)tok * 256) + lane),
                    ow = *((const f32x4*)((const float*)(a.ws + WS_OWIN) + (size_t)tok * 256) + lane);
        const f32x4 v = oc * g0 + os * g1 + ow * g2;
        float rstd = rsqrtf(wave_sum((v.x * v.x + v.y * v.y) + (v.z * v.z + v.w * v.w)) * (1.f / 256.f) + RMS_EPS);
        f32x4 gv = *((const f32x4*)gg + lane);
        v2u w; w.x = pk2(v.x * rstd * gv.x, v.y * rstd * gv.y); w.y = pk2(v.z * rstd * gv.z, v.w * rstd * gv.w);
        *((v2u*)(MIX + (size_t)tok * DM) + lane) = w;
        const f32x4 s0 = *((const f32x4*)((const float*)(a.ws + WS_OSWA) + (size_t)tok * 512) + 2 * lane), s1 = *((const f32x4*)((const float*)(a.ws + WS_OSWA) + (size_t)tok * 512) + 2 * lane + 1);
        rstd = rsqrtf(wave_sum(((s0.x * s0.x + s0.y * s0.y) + (s0.z * s0.z + s0.w * s0.w)) + ((s1.x * s1.x + s1.y * s1.y) + (s1.z * s1.z + s1.w * s1.w))) * (1.f / 512.f) + RMS_EPS);
        const f32x4 ga = *((const f32x4*)(gg + 256) + 2 * lane), gb = *((const f32x4*)(gg + 256) + 2 * lane + 1);
        v4u w4; w4.x = pk2(s0.x * rstd * ga.x, s0.y * rstd * ga.y); w4.y = pk2(s0.z * rstd * ga.z, s0.w * rstd * ga.w); w4.z = pk2(s1.x * rstd * gb.x, s1.y * rstd * gb.y); w4.w = pk2(s1.z * rstd * gb.z, s1.w * rstd * gb.w);
        *((v4u*)(MIX + (size_t)tok * DM + 256) + lane) = w4;
        const f32x4 sb = *((const f32x4*)((const float*)(a.ws + WS_OSB) + (size_t)tok * 256) + lane);
        rstd = rsqrtf(wave_sum((sb.x * sb.x + sb.y * sb.y) + (sb.z * sb.z + sb.w * sb.w)) * (1.f / 256.f) + RMS_EPS);
        gv = *((const f32x4*)(gg + 768) + lane);
        w.x = pk2(sb.x * rstd * gv.x, sb.y * rstd * gv.y); w.y = pk2(sb.z * rstd * gv.z, sb.w * rstd * gv.w);
        *((v2u*)(MIX + (size_t)tok * DM + 768) + lane) = w;
    }
}
__device__ __forceinline__ void p_postnorm(const Args& a, const float* xold, const float* gpost, const float* gnext, int lane, int wave) {
    const bf16* F = (const bf16*)(a.ws + WS_F); bf16* XN = (bf16*)(a.ws + WS_XN);
    const int gw = blockIdx.x * NWAVES + wave, NGW = gridDim.x * NWAVES;
    for (int tok = gw; tok < M; tok += NGW) {
        f32x4 f[4]; float s = 0.f;
#pragma unroll
        for (int j = 0; j < 4; ++j) { const v2u w = *((const v2u*)(F + (size_t)tok * DM) + lane + 64 * j); f[j] = (f32x4){bf_lo(w.x), bf_hi(w.x), bf_lo(w.y), bf_hi(w.y)};
            s += (f[j].x * f[j].x + f[j].y * f[j].y) + (f[j].z * f[j].z + f[j].w * f[j].w); }
        const float rstd = rsqrtf(wave_sum(s) * (1.f / DM) + RMS_EPS);
        float s2 = 0.f;
#pragma unroll
        for (int j = 0; j < 4; ++j) { const f32x4 xo = *((const f32x4*)(xold + (size_t)tok * DM) + lane + 64 * j); const f32x4 gp = *((const f32x4*)gpost + lane + 64 * j);
            f[j] = xo + f[j] * rstd * gp; *((f32x4*)(a.out + (size_t)tok * DM) + lane + 64 * j) = f[j];
            s2 += (f[j].x * f[j].x + f[j].y * f[j].y) + (f[j].z * f[j].z + f[j].w * f[j].w); }
        if (gnext) { const float r2 = rsqrtf(wave_sum(s2) * (1.f / DM) + RMS_EPS);
#pragma unroll
            for (int j = 0; j < 4; ++j) { const f32x4 gn = *((const f32x4*)gnext + lane + 64 * j); v2u w; w.x = pk2(f[j].x * r2 * gn.x, f[j].y * r2 * gn.y); w.y = pk2(f[j].z * r2 * gn.z, f[j].w * r2 * gn.w);
                *((v2u*)(XN + (size_t)tok * DM) + lane + 64 * j) = w; } }
    }
}

__global__ void __launch_bounds__(NWAVES * 64, 2) hyb_fwd(Args args) {
    extern __shared__ __attribute__((aligned(16))) unsigned char lds_raw[];
    LAS unsigned char* lds = (LAS unsigned char*)lds_raw;
    const int tid = threadIdx.x, lane = tid & 63, wave = __builtin_amdgcn_readfirstlane(tid >> 6);
    const int G = gridDim.x;
    for (int u = tid; u < (LDS_BYTES - LDSCTL_OFF) / 4; u += NWAVES * 64) ((LAS unsigned*)(lds + LDSCTL_OFF))[u] = 0u;
    __syncthreads();
    unsigned* ctl = (unsigned*)(args.ws + WS_CTL);
    XcdBarrier bar = xcd_barrier_post(ctl + CW_BAR + args.li * XCD_BAR_WORDS, (volatile LAS unsigned*)(lds + MISC_OFF) + 8);
    const int lo = args.ph_lo, hi = args.ph_hi;
#define IN(k) (lo <= (k) && (k) < hi)
#define LAUNDER int tid_ = tid; asm volatile("" : "+v"(tid_)); const int lane_ = tid_ & 63, wave_ = __builtin_amdgcn_readfirstlane(tid_ >> 6)
#define SEAM(k) do { if ((k) + 1 < hi) xcd_barrier(bar); else { VM_WAIT(); __syncthreads(); } } while (0)
    unsigned char* ws = args.ws;
    if ((PHMASK & 1) && IN(0)) { LAUNDER; p0_prologue(args, lds, tid_, lane_, wave_); SEAM(0); }
    for (int l = 0; l < DEPTH; ++l) {
        const int pb = 1 + 11 * l;
        if (((PHMASK >> 1) & 1) && IN(pb + 0)) {
            pg8::Gemm g{(const pg8::bf16_t*)(ws + WS_XN), (const pg8::bf16_t*)(ws + WS_WIN) + (size_t)l * INP * DM, M, INP, DM, (size_t)DM * 2, 128};
            pg8::StaticOrder S; S.init(M, INP, G, (int)blockIdx.x);
            pg8::EpiBf16<0> E{(pg8::bf16_t*)(ws + WS_PROJ), INP, nullptr};
            pg8::gemm_phase<pg8::EpiBf16<0>, pg8::StaticOrder, true, true>(lds + RING_OFF, g, S, E);
            SEAM(pb + 0);
        }
        if (((PHMASK >> 2) & 1) && IN(pb + 1)) {
            pg8::StaticOrder S; S.init(2 * NCP, 256, G, (int)blockIdx.x);
            { pg8::Gemm g{(const pg8::bf16_t*)(ws + WS_PROJ) + C_KC, (const pg8::bf16_t*)(ws + WS_W1) + (size_t)(l * 2 + 0) * 256 * 2048, 2 * NCP, 256, 2048, (size_t)16 * INP * 2, (size_t)INP * 2};
              pg8::EpiBf16<2> E{(pg8::bf16_t*)(ws + WS_HIDC), 256, (const float*)(ws + WS_POSB) + (l * 2 + 0) * 256};
              pg8::gemm_phase<pg8::EpiBf16<2>, pg8::StaticOrder, true, true>(lds + RING_OFF, g, S, E); }
            pg8::StaticOrder S2; S2.init(2 * NCP, 256, G, (int)((blockIdx.x + G / 2) % G));
            { pg8::Gemm g{(const pg8::bf16_t*)(ws + WS_PROJ) + C_VC, (const pg8::bf16_t*)(ws + WS_W1) + (size_t)(l * 2 + 1) * 256 * 2048, 2 * NCP, 256, 2048, (size_t)16 * INP * 2, (size_t)INP * 2};
              pg8::EpiBf16<2> E{(pg8::bf16_t*)(ws + WS_HIDC) + (size_t)2 * NCP * 256, 256, (const float*)(ws + WS_POSB) + (l * 2 + 1) * 256};
              pg8::gemm_phase<pg8::EpiBf16<2>, pg8::StaticOrder, true, true>(lds + RING_OFF, g, S2, E); }
            SEAM(pb + 1);
        }
        if (((PHMASK >> 3) & 1) && IN(pb + 2)) { LAUNDER; p_compress2(args, l, tid_); SEAM(pb + 2); }
        if (((PHMASK >> 4) & 1) && IN(pb + 3)) { for (int rep = 0; rep < 1 + ((REPMASK >> 4) & 1); ++rep) { LAUNDER;
#if USE_MFMA_A
            p_attn_a_mfma(args, l, lds, tid_, lane_, wave_);
#else
            p_attn_a(args, l, lds, tid_, lane_, wave_);
#endif
            SEAM(pb + 3); } }
        if (((PHMASK >> 5) & 1) && IN(pb + 4)) { for (int rep = 0; rep < 1 + ((REPMASK >> 5) & 1); ++rep) { LAUNDER; p_attn_b(args, lds, tid_, lane_, wave_); SEAM(pb + 4); } }
        if (((PHMASK >> 6) & 1) && IN(pb + 5)) { LAUNDER; p_groupnorm(args, l, lane_, wave_); SEAM(pb + 5); }
        if (((PHMASK >> 7) & 1) && IN(pb + 6)) {
            pg8::Gemm g{(const pg8::bf16_t*)(ws + WS_XN), (const pg8::bf16_t*)(ws + WS_WOUT) + (size_t)l * DM * DM, M, DM, DM, (size_t)DM * 2, 128};
            pg8::StaticOrder S; S.init(M, DM, G, (int)blockIdx.x);
            pg8::EpiBf16<0> E{(pg8::bf16_t*)(ws + WS_F), DM, nullptr};
            pg8::gemm_phase<pg8::EpiBf16<0>, pg8::StaticOrder, true, true>(lds + RING_OFF, g, S, E);
            SEAM(pb + 6);
        }
        if (((PHMASK >> 8) & 1) && IN(pb + 7)) {
            LAUNDER; p_postnorm(args, l == 0 ? args.in[I_X] : args.out, args.in[I_LNAPOST] + (size_t)l * DM, args.in[I_LNFP] + (size_t)l * DM, lane_, wave_); SEAM(pb + 7);
        }
        if (((PHMASK >> 9) & 1) && IN(pb + 8)) {
            pg8::Gemm g{(const pg8::bf16_t*)(ws + WS_XN), (const pg8::bf16_t*)(ws + WS_WGU) + (size_t)l * NGU * DM, M, NGU, DM, (size_t)DM * 2, 128};
            pg8::StaticOrder S; S.init(M, NGU, G, (int)blockIdx.x);
            pg8::EpiSwiGLU E{(pg8::bf16_t*)(ws + WS_HID), DFF};
            pg8::gemm_phase<pg8::EpiSwiGLU, pg8::StaticOrder, true, true>(lds + RING_OFF, g, S, E);
            SEAM(pb + 8);
        }
        if (((PHMASK >> 10) & 1) && IN(pb + 9)) {
            pg8::Gemm g{(const pg8::bf16_t*)(ws + WS_HID), (const pg8::bf16_t*)(ws + WS_WDN) + (size_t)l * DM * DFF, M, DM, DFF, (size_t)DFF * 2, 128};
            pg8::StaticOrder S; S.init(M, DM, G, (int)blockIdx.x);
            pg8::EpiBf16<0> E{(pg8::bf16_t*)(ws + WS_F), DM, nullptr};
            pg8::gemm_phase<pg8::EpiBf16<0>, pg8::StaticOrder, true, true>(lds + RING_OFF, g, S, E);
            SEAM(pb + 9);
        }
        if (((PHMASK >> 11) & 1) && IN(pb + 10)) {
            LAUNDER; p_postnorm(args, args.out, args.in[I_LNFPOST] + (size_t)l * DM, l + 1 < DEPTH ? args.in[I_LNAP] + (size_t)(l + 1) * DM : nullptr, lane_, wave_); SEAM(pb + 10);
        }
    }
#undef IN
#undef SEAM
}

#ifndef PHMASK
#define PHMASK 0xFFF
#endif
#ifndef MK_ONE_LAUNCH
#define MK_ONE_LAUNCH 1
#endif
extern "C" void kernel_launch(void* const* d_in, const int* in_sizes, int n_in, void* d_out, int out_size, void* d_ws, size_t ws_size, hipStream_t stream) {
    static int grid = 0;
    if (grid == 0) {
        if (n_in != 17 || in_sizes[0] != M * DM || out_size != M * DM || ws_size < WS_END) { fprintf(stderr, "kernel_launch: unexpected shapes (n_in %d, in0 %d, out %d, ws %zu); nothing launched\n", n_in, n_in > 0 ? in_sizes[0] : -1, out_size, ws_size); grid = -1; return; }
        int dev = 0, cus = 0, per_cu = 0;
        if (hipGetDevice(&dev) != hipSuccess || hipDeviceGetAttribute(&cus, hipDeviceAttributeMultiprocessorCount, dev) != hipSuccess) { grid = -1; return; }
        if (hipFuncSetAttribute((const void*)hyb_fwd, hipFuncAttributeMaxDynamicSharedMemorySize, LDS_BYTES) != hipSuccess) { fprintf(stderr, "kernel_launch: hipFuncSetAttribute failed\n"); grid = -1; return; }
        if (hipOccupancyMaxActiveBlocksPerMultiprocessor(&per_cu, (const void*)hyb_fwd, NWAVES * 64, LDS_BYTES) != hipSuccess || per_cu < 1) fprintf(stderr, "kernel_launch: occupancy query reports %d workgroups per CU\n", per_cu);
        (void)hipGetLastError();
        grid = cus;
    }
    if (grid < 0) return;
    if (hipMemsetAsync((char*)d_ws + WS_CTL, 0, CTL_ZERO_BYTES, stream) != hipSuccess) return;
    Args a{};
    for (int i = 0; i < 17; ++i) a.in[i] = (const float*)d_in[i];
    a.out = (float*)d_out; a.ws = (unsigned char*)d_ws;
#if MK_ONE_LAUNCH
    a.ph_lo = 0; a.ph_hi = NPH; a.li = 0;
    hipLaunchKernelGGL(hyb_fwd, dim3(grid), dim3(NWAVES * 64), LDS_BYTES, stream, a);
#else
    for (int p = 0; p < NPH; ++p) { a.ph_lo = p; a.ph_hi = p + 1; a.li = p;
        hipLaunchKernelGGL(hyb_fwd, dim3(grid), dim3(NWAVES * 64), LDS_BYTES, stream, a); }
#endif
}
```

```cpp
#include <hip/hip_runtime.h>
#include <cstdio>
#include <cstdint>
#ifndef PHMASK
#define PHMASK 0xFFF
#endif
#ifndef USE_MFMA_A
#define USE_MFMA_A 1
#endif
#ifndef USE_MFMA_B
#define USE_MFMA_B 1
#endif
#ifndef REPMASK
#define REPMASK 0
#endif
namespace pg8 {
#define PG8_LAS __attribute__((address_space(3)))
typedef unsigned short bf16_t;
typedef short bf16x8 __attribute__((ext_vector_type(8)));
typedef float f32x4 __attribute__((ext_vector_type(4)));
typedef unsigned u32x4 __attribute__((ext_vector_type(4)));
constexpr int BM = 256, BK = 64, HALF = 128, HTB = HALF * BK * 2  , STAGE_BYTES = 8 * HTB, NXCD = 8, WGM = 8;

__host__ __device__ __forceinline__ int lds_byte(int r, int c) { const int st = (r >> 4) * 2 + (c >> 5), rr = r & 15, cc = c & 31, ob = rr * 64 + cc * 2; return st * 1024 + (ob ^ (((ob >> 9) & 1) << 5)); }
__host__ __device__ __forceinline__ void stage_rc(int b, int& R, int& C) { const int st = b / 1024, sb = b % 1024, swz = sb ^ (((sb >> 9) & 1) << 5); R = (st >> 1) * 16 + swz / 64; C = (st & 1) * 32 + (swz % 64) / 2; }
__host__ __device__ __forceinline__ int perm32(int rho) { const int n = rho >> 4, i = rho & 15; return 8 * (i >> 2) + 4 * n + (i & 3); }

struct Unit { int pm, pn; };
struct Gemm { const bf16_t* A; const bf16_t* Bt; int M, N, K; size_t a_row_bytes, a_kstep_bytes; };

struct StaticOrder {
    int nM, nN, nwg, G, c;
    __host__ __device__ void init(int M, int N, int G_, int c_) { nM = M / BM; nN = N / BM; nwg = nM * nN; G = G_; c = c_; }
    __host__ __device__ bool next(int i, Unit& u) const {
        const long L = (long)i * G + c; if (L >= nwg) return false;
        int wgid = (int)L; { const int q = nwg / NXCD, r = nwg % NXCD, xcd = wgid % NXCD, off = wgid / NXCD; wgid = (xcd < r ? xcd * (q + 1) : r * (q + 1) + (xcd - r) * q) + off; }
        const int nig = WGM * nN, gid = wgid / nig, fm = gid * WGM, gsz = (nM - fm) < WGM ? (nM - fm) : WGM;
        u.pm = fm + ((wgid % nig) % gsz); u.pn = (wgid % nig) / gsz; return true;
    }
    __device__ __forceinline__ void a_ready(const Unit&) const {}
    __device__ __forceinline__ void done(const Unit&) const {}
};

__device__ __forceinline__ unsigned cvt_pk_bf16(float lo, float hi) { unsigned r; asm volatile("v_cvt_pk_bf16_f32 %0, %1, %2" : "=v"(r) : "v"(lo), "v"(hi)); return r; }
typedef float f32x2 __attribute__((ext_vector_type(2)));
__device__ __forceinline__ float silu_f(float x) { return x * __builtin_amdgcn_rcpf(1.0f + __expf(-x)); }
template <int ACT  > struct EpiBf16 {
    static constexpr bool PERM = true, AFTER_DRAIN = false;
    bf16_t* O; int ldc; const float* bias;
    __device__ __forceinline__ void operator()(const f32x4 (&acc)[2][2][4][2], const Unit& u, int wr, int wc, int fr, int fq) const {
        const int row0 = u.pm * BM + wr * 64 + fr; const int col0 = u.pn * BM + wc * 32 + 8 * fq;
        f32x4 bv[2][2];
#pragma unroll
        for (int bj = 0; bj < 2; ++bj)
#pragma unroll
            for (int n = 0; n < 2; ++n) bv[bj][n] = bias ? *(const f32x4*)(bias + col0 + bj * HALF + 4 * n) : (f32x4){0.f, 0.f, 0.f, 0.f};
#pragma unroll
        for (int ai = 0; ai < 2; ++ai)
#pragma unroll
            for (int m = 0; m < 4; ++m) { bf16_t* rowp = O + (size_t)(row0 + ai * HALF + m * 16) * ldc + col0;
#pragma unroll
                for (int bj = 0; bj < 2; ++bj) { f32x4 v0 = acc[ai][bj][m][0] + bv[bj][0], v1 = acc[ai][bj][m][1] + bv[bj][1];
                    if (ACT == 2) { v0 = (f32x4){silu_f(v0[0]), silu_f(v0[1]), silu_f(v0[2]), silu_f(v0[3])}; v1 = (f32x4){silu_f(v1[0]), silu_f(v1[1]), silu_f(v1[2]), silu_f(v1[3])}; }
                    u32x4 w; w.x = cvt_pk_bf16(v0[0], v0[1]); w.y = cvt_pk_bf16(v0[2], v0[3]); w.z = cvt_pk_bf16(v1[0], v1[1]); w.w = cvt_pk_bf16(v1[2], v1[3]);
                    *(u32x4*)(rowp + bj * HALF) = w; } }
    }
};
struct EpiSwiGLU {
    static constexpr bool PERM = true, AFTER_DRAIN = false;
    bf16_t* O; int ldc;
    __device__ __forceinline__ void operator()(const f32x4 (&acc)[2][2][4][2], const Unit& u, int wr, int wc, int fr, int fq) const {
        const int row0 = u.pm * BM + wr * 64 + fr; const int col0 = u.pn * HALF + wc * 32 + 8 * fq;
#pragma unroll
        for (int ai = 0; ai < 2; ++ai)
#pragma unroll
            for (int m = 0; m < 4; ++m) { bf16_t* rowp = O + (size_t)(row0 + ai * HALF + m * 16) * ldc + col0;
                const f32x4 g0 = acc[ai][0][m][0], g1 = acc[ai][0][m][1], u0 = acc[ai][1][m][0], u1 = acc[ai][1][m][1];
                u32x4 w; w.x = cvt_pk_bf16(silu_f(g0[0]) * u0[0], silu_f(g0[1]) * u0[1]); w.y = cvt_pk_bf16(silu_f(g0[2]) * u0[2], silu_f(g0[3]) * u0[3]);
                w.z = cvt_pk_bf16(silu_f(g1[0]) * u1[0], silu_f(g1[1]) * u1[1]); w.w = cvt_pk_bf16(silu_f(g1[2]) * u1[2], silu_f(g1[3]) * u1[3]);
                *(u32x4*)rowp = w; }
    }
};
template <class Epi, class Sched, bool ALIGN_EPI = false, bool SP2 = false>
__device__ __forceinline__ void gemm_phase(PG8_LAS unsigned char* lds, const Gemm g, const Sched& S, const Epi& E) {
    int tid_l = threadIdx.x; asm volatile("" : "+v"(tid_l));
    const int tid = tid_l, wid = __builtin_amdgcn_readfirstlane(tid >> 6), lane = tid & 63, wr = wid >> 2, wc = wid & 3, fr = lane & 15, fq = lane >> 4;
    const int K = g.K, nt = K / BK;
    unsigned voffA[2], voffB[2];
#pragma unroll
    for (int i = 0; i < 2; ++i) { int R, C; stage_rc(tid * 16 + i * 8192, R, C); const int Rb = Epi::PERM ? ((R & ~31) + perm32(R & 31)) : R;
        voffA[i] = (unsigned)((size_t)R * g.a_row_bytes + (size_t)C * 2u); voffB[i] = (unsigned)(Rb * K + C) * 2u; }
    const size_t kstepB = (size_t)(BK * 2), kstepA = g.a_kstep_bytes;
    const size_t hstepB = (size_t)HALF * K * 2, hstepA = (size_t)HALF * g.a_row_bytes;
    const size_t tstepB = 2 * hstepB, tstepA = 2 * hstepA;
    const unsigned ldsw = (unsigned)wid * 1024u;
    const int aoff = lds_byte(wr * 64 + fr, fq * 8), boff = lds_byte(wc * 32 + fr, fq * 8);
#define PG8_SA(b, h) (((b) * 2 + (h)) * HTB)
#define PG8_SB(b, h) ((4 + (b) * 2 + (h)) * HTB)
#define PG8_STAGE(bufoff, gbase, voff) do { _Pragma("unroll") for (int _i = 0; _i < 2; ++_i) \
        __builtin_amdgcn_global_load_lds((const unsigned*)((const char*)(gbase) + (voff)[_i]), (PG8_LAS unsigned*)(lds + (bufoff) + ldsw + _i * 8192), 16, 0, 0); } while (0)
#define PG8_LDA(dst, b, h) do { _Pragma("unroll") for (int m = 0; m < 4; ++m) _Pragma("unroll") for (int k = 0; k < 2; ++k) dst[m][k] = *(const PG8_LAS bf16x8*)(lds + PG8_SA(b, h) + aoff + m * 2048 + k * 1024); } while (0)
#define PG8_LDB(dst, b, h) do { _Pragma("unroll") for (int n = 0; n < 2; ++n) _Pragma("unroll") for (int k = 0; k < 2; ++k) dst[n][k] = *(const PG8_LAS bf16x8*)(lds + PG8_SB(b, h) + boff + n * 2048 + k * 1024); } while (0)
#define PG8_MMA(ai, bj, At, Bt) do { __builtin_amdgcn_s_setprio(1); _Pragma("unroll") for (int m = 0; m < 4; ++m) _Pragma("unroll") for (int n = 0; n < 2; ++n) _Pragma("unroll") for (int k = 0; k < 2; ++k) \
        acc[ai][bj][m][n] = __builtin_amdgcn_mfma_f32_16x16x32_bf16(Bt[n][k], At[m][k], acc[ai][bj][m][n], 0, 0, 0); __builtin_amdgcn_s_setprio(0); } while (0)
#define PG8_WAIT_V(n) asm volatile("s_waitcnt vmcnt(" #n ")" ::: "memory")
#define PG8_WAIT_L(n) asm volatile("s_waitcnt lgkmcnt(" #n ")" ::: "memory")
#define PG8_BAR __builtin_amdgcn_s_barrier()
#define PG8_SCHED __builtin_amdgcn_sched_barrier(0)
    Unit cur, nxt; int ui = 0;
    if (!S.next(0, cur)) return;
    f32x4 acc[2][2][4][2];
#pragma unroll
    for (int a = 0; a < 2; ++a)
#pragma unroll
        for (int b = 0; b < 2; ++b)
#pragma unroll
            for (int m = 0; m < 4; ++m)
#pragma unroll
                for (int n = 0; n < 2; ++n) acc[a][b][m][n] = (f32x4){0.f, 0.f, 0.f, 0.f};
    bf16x8 At[4][2], B0[2][2], B1[2][2];
    const char* cA = (const char*)g.A + (size_t)cur.pm * tstepA; const char* cB = (const char*)g.Bt + (size_t)cur.pn * tstepB;
    S.a_ready(cur);
    if constexpr (SP2) {
        PG8_STAGE(PG8_SB(0, 0), cB, voffB); PG8_STAGE(PG8_SB(0, 1), cB + hstepB, voffB); PG8_STAGE(PG8_SA(0, 0), cA, voffA); PG8_STAGE(PG8_SA(0, 1), cA + hstepA, voffA);
        if (wr == 1) PG8_BAR;
        PG8_WAIT_V(2); PG8_BAR;
        PG8_STAGE(PG8_SB(1, 0), cB + kstepB, voffB); PG8_STAGE(PG8_SA(1, 0), cA + kstepA, voffA); PG8_STAGE(PG8_SB(1, 1), cB + hstepB + kstepB, voffB);
        PG8_WAIT_V(6); PG8_BAR;
    } else {
        PG8_STAGE(PG8_SB(0, 0), cB, voffB); PG8_STAGE(PG8_SA(0, 0), cA, voffA); PG8_STAGE(PG8_SB(0, 1), cB + hstepB, voffB); PG8_STAGE(PG8_SA(0, 1), cA + hstepA, voffA);
        if (wr == 1) PG8_BAR;
        PG8_WAIT_V(4); PG8_BAR;
        PG8_STAGE(PG8_SB(1, 0), cB + kstepB, voffB); PG8_STAGE(PG8_SA(1, 0), cA + kstepA, voffA); PG8_STAGE(PG8_SB(1, 1), cB + hstepB + kstepB, voffB);
        PG8_WAIT_V(6); PG8_BAR;
    }
    for (;;) {
        const bool has_next = S.next(ui + 1, nxt);
        const char* nA = has_next ? (const char*)g.A + (size_t)nxt.pm * tstepA : cA; const char* nB = has_next ? (const char*)g.Bt + (size_t)nxt.pn * tstepB : cB;
        for (int t = 0; t < nt; t += 2) {
            const bool last = (t == nt - 2);
            const char* a1 = cA + (size_t)(t + 1) * kstepA;
            const char* a2 = last ? nA : cA + (size_t)(t + 2) * kstepA; const char* b2 = last ? nB : cB + (size_t)(t + 2) * kstepB;
            const char* a3 = a2 + kstepA; const char* b3 = b2 + kstepB;
            if (last && has_next) S.a_ready(nxt);
            if constexpr (SP2) {
            PG8_LDB(B0, 0, 0); PG8_LDB(B1, 0, 1); PG8_SCHED; PG8_LDA(At, 0, 0); PG8_STAGE(PG8_SA(1, 1), a1 + hstepA, voffA);
            PG8_WAIT_V(8); PG8_WAIT_L(0); PG8_BAR; PG8_MMA(0, 0, At, B0); PG8_MMA(0, 1, At, B1); PG8_BAR; PG8_SCHED;
            PG8_LDA(At, 0, 1); PG8_STAGE(PG8_SB(0, 0), b2, voffB); PG8_STAGE(PG8_SB(0, 1), b2 + hstepB, voffB); PG8_STAGE(PG8_SA(0, 0), a2, voffA);
            PG8_WAIT_V(8); PG8_WAIT_L(0); PG8_BAR; PG8_MMA(1, 0, At, B0); PG8_MMA(1, 1, At, B1); PG8_BAR; PG8_SCHED;
            PG8_LDB(B0, 1, 0); PG8_LDB(B1, 1, 1); PG8_SCHED; PG8_LDA(At, 1, 0); PG8_STAGE(PG8_SA(0, 1), a2 + hstepA, voffA);
            PG8_WAIT_V(8); PG8_WAIT_L(0); PG8_BAR; PG8_MMA(0, 0, At, B0); PG8_MMA(0, 1, At, B1); PG8_BAR; PG8_SCHED;
            PG8_LDA(At, 1, 1); PG8_STAGE(PG8_SB(1, 0), b3, voffB); PG8_STAGE(PG8_SB(1, 1), b3 + hstepB, voffB); PG8_STAGE(PG8_SA(1, 0), a3, voffA);
            PG8_WAIT_V(8); PG8_WAIT_L(0); PG8_BAR; PG8_MMA(1, 0, At, B0); PG8_MMA(1, 1, At, B1); PG8_BAR; PG8_SCHED;
            } else {
            PG8_LDB(B0, 0, 0); PG8_SCHED; PG8_LDA(At, 0, 0); PG8_STAGE(PG8_SA(1, 1), a1 + hstepA, voffA);
            PG8_WAIT_L(8); PG8_BAR; PG8_WAIT_L(0); PG8_MMA(0, 0, At, B0); PG8_BAR; PG8_SCHED;
            PG8_LDB(B1, 0, 1); PG8_STAGE(PG8_SB(0, 0), b2, voffB);
            PG8_BAR; PG8_WAIT_L(0); PG8_MMA(0, 1, At, B1); PG8_BAR;
            PG8_LDA(At, 0, 1); PG8_STAGE(PG8_SA(0, 0), a2, voffA);
            PG8_BAR; PG8_WAIT_L(0); PG8_MMA(1, 0, At, B0); PG8_BAR; PG8_SCHED;
            PG8_STAGE(PG8_SB(0, 1), b2 + hstepB, voffB);
            PG8_WAIT_V(6); PG8_BAR; PG8_MMA(1, 1, At, B1); PG8_BAR;
            PG8_LDB(B0, 1, 0); PG8_SCHED; PG8_LDA(At, 1, 0); PG8_STAGE(PG8_SA(0, 1), a2 + hstepA, voffA);
            PG8_WAIT_L(8); PG8_BAR; PG8_WAIT_L(0); PG8_MMA(0, 0, At, B0); PG8_BAR; PG8_SCHED;
            PG8_LDB(B1, 1, 1); PG8_STAGE(PG8_SB(1, 0), b3, voffB);
            PG8_BAR; PG8_WAIT_L(0); PG8_MMA(0, 1, At, B1); PG8_BAR;
            PG8_LDA(At, 1, 1); PG8_STAGE(PG8_SA(1, 0), a3, voffA);
            PG8_BAR; PG8_WAIT_L(0); PG8_MMA(1, 0, At, B0); PG8_BAR; PG8_SCHED;
            PG8_STAGE(PG8_SB(1, 1), b3 + hstepB, voffB);
            PG8_WAIT_V(6); PG8_BAR; PG8_MMA(1, 1, At, B1); PG8_BAR;
            }
        }
        if constexpr (ALIGN_EPI) { if (wr == 0) PG8_BAR; }
        if constexpr (!Epi::AFTER_DRAIN) { E(acc, cur, wr, wc, fr, fq); S.done(cur); }
        if (!has_next) break;
#pragma unroll
        for (int a = 0; a < 2; ++a)
#pragma unroll
            for (int b = 0; b < 2; ++b)
#pragma unroll
                for (int m = 0; m < 4; ++m)
#pragma unroll
                    for (int n = 0; n < 2; ++n) acc[a][b][m][n] = (f32x4){0.f, 0.f, 0.f, 0.f};
        cur = nxt; cA = nA; cB = nB; ++ui;
        if constexpr (ALIGN_EPI) { if (wr == 1) PG8_BAR; }
    }
    PG8_WAIT_V(0);
    if constexpr (!ALIGN_EPI) { if (wr == 0) PG8_BAR; }
    PG8_BAR;
    if constexpr (Epi::AFTER_DRAIN) { E.fused(acc, cur, wr, wc, fr, fq, lds, wid, lane); S.done(cur); }
#undef PG8_SA
#undef PG8_SB
#undef PG8_STAGE
#undef PG8_LDA
#undef PG8_LDB
#undef PG8_MMA
#undef PG8_WAIT_V
#undef PG8_WAIT_L
#undef PG8_BAR
#undef PG8_SCHED
}
}
constexpr int NWAVES = 8;
constexpr int BATCH = 2, SEQ = 16384, DM = 1024, DEPTH = 2, M = BATCH * SEQ, HD = 64;
constexpr int INW = 2188, INP = 2304, DFF = 2816, NGU = 2 * DFF;
constexpr int C_NQ = 0, C_KC = 256, C_VC = 320, C_KS = 384, C_VS = 448, C_KW = 512, C_VW = 576, C_SQ = 640, C_SK = 1152, C_SV = 1280, C_BQ = 1408, C_BK = 1664, C_BV = 1920, C_NG = 2176;
constexpr int NCP = 1024;
constexpr float RMS_EPS = 1e-6f;
constexpr int NPH = 1 + 9 * DEPTH;

constexpr size_t MiB = 1u << 20;
constexpr size_t WS_CTL = 0, CTL_ZERO_BYTES = 1 * MiB;
constexpr size_t WS_WIN = 2 * MiB, WS_WOUT = 11 * MiB, WS_WGU = 15 * MiB, WS_WDN = 37 * MiB, WS_W1 = 48 * MiB, WS_POSB = 52 * MiB, WS_KVC = 53 * MiB, WS_HIDC = 54 * MiB, WS_KVCB = 56 * MiB, WS_IDX = 58 * MiB, WS_W2T = 52 * MiB + 65536;
constexpr size_t WS_XN = 64 * MiB, WS_PROJ = 128 * MiB, WS_HID = 128 * MiB, WS_IMP = 272 * MiB;
constexpr size_t WS_OCMP = 304 * MiB, WS_OSLC = 336 * MiB, WS_OWIN = 368 * MiB, WS_OSWA = 400 * MiB, WS_OSB = 464 * MiB, WS_F = 304 * MiB, WS_END = 496 * MiB;
static_assert(WS_WIN + (size_t)DEPTH * INP * DM * 2 <= WS_WOUT && WS_WOUT + (size_t)DEPTH * DM * DM * 2 <= WS_WGU && WS_WGU + (size_t)DEPTH * NGU * DM * 2 <= WS_WDN && WS_WDN + (size_t)DEPTH * DM * DFF * 2 <= WS_W1 && WS_W1 + (size_t)DEPTH * 2 * 256 * 2048 * 2 <= WS_POSB, "weights map");
static_assert(WS_PROJ + (size_t)M * INP * 2 <= WS_IMP && WS_HID + (size_t)M * DFF * 2 <= WS_OCMP && WS_IMP + (size_t)M * 256 * 4 <= WS_OCMP && WS_OSB + (size_t)M * 256 * 4 <= WS_END, "activation map");
constexpr int CW_BAR = 4096;

constexpr int RING_OFF = 0, RING_BYTES = 131072;
constexpr int LDSCTL_OFF = RING_BYTES, MISC_OFF = LDSCTL_OFF + 320;
constexpr int LDS_BYTES = 147456;

#define GAS __attribute__((address_space(1)))
#define LAS __attribute__((address_space(3)))
typedef unsigned short bf16;
typedef unsigned v4u __attribute__((ext_vector_type(4)));
typedef unsigned v2u __attribute__((ext_vector_type(2)));
typedef float f32x4 __attribute__((ext_vector_type(4)));
typedef GAS unsigned gu32;
#define LDS_WAIT() asm volatile("s_waitcnt lgkmcnt(0)" ::: "memory")
#define VM_WAIT() asm volatile("s_waitcnt vmcnt(0)" ::: "memory")
__device__ __forceinline__ unsigned f2bf(float f) { unsigned u = __builtin_bit_cast(unsigned, f); return (u + 0x7fffu + ((u >> 16) & 1u)) >> 16; }
__device__ __forceinline__ unsigned pk2(float lo, float hi) { return f2bf(lo) | (f2bf(hi) << 16); }
__device__ __forceinline__ float bf_lo(unsigned u) { return __uint_as_float(u << 16); }
__device__ __forceinline__ float bf_hi(unsigned u) { return __uint_as_float(u & 0xffff0000u); }
__device__ __forceinline__ float bf1(bf16 b) { return __uint_as_float(((unsigned)b) << 16); }

#define XB_TMO      128
#define XB_XCNT(j)  (256  + 64 * (j))
#define XB_XSUB(j)  (1280 + 64 * (j))
#define XB_XGEN(j)  (2304 + 64 * (j))
#define XB_TOP      3328
#define XB_TOPGEN   3392
#define XCD_BAR_WORDS 3456
#define XB_SPIN_CAP (1u << 18)
__device__ __forceinline__ unsigned xb_ld(unsigned* p)              { return __hip_atomic_load(p, __ATOMIC_RELAXED, __HIP_MEMORY_SCOPE_AGENT); }
__device__ __forceinline__ unsigned xb_add(unsigned* p, unsigned v) { return __hip_atomic_fetch_add(p, v, __ATOMIC_RELAXED, __HIP_MEMORY_SCOPE_AGENT); }
__device__ __forceinline__ unsigned xb_xcc_id() { return (unsigned)__builtin_amdgcn_s_getreg((3 << 11) | 20) & 0xFu; }
#define XB_SPIN(cond, bar) do { unsigned _sp = 0; while (cond) { __builtin_amdgcn_s_sleep(1); \
    if ((++_sp & 255u) == 0u) { if (xb_ld(&(bar)[XB_TMO])) break; if (_sp > XB_SPIN_CAP) { atomicAdd(&(bar)[XB_TMO], 1u); break; } } } } while (0)
struct XcdBarrier { unsigned* bar; unsigned x; volatile LAS unsigned* st; };
__device__ __forceinline__ XcdBarrier xcd_barrier_post(unsigned* bar, volatile LAS unsigned* st) {
    XcdBarrier b; b.bar = bar; b.x = xb_xcc_id(); b.st = st;
    if (threadIdx.x == 0) (void)xb_add(&bar[XB_XCNT(b.x)], 1u);
    return b;
}
__device__ __forceinline__ void xcd_barrier_complete(unsigned* bar, unsigned x, unsigned& nloc, unsigned& nx) {
    const unsigned G = gridDim.x * gridDim.y * gridDim.z;
    unsigned sum, cnt, mine, sp = 0u;
    for (;;) {
        sum = 0u; cnt = 0u; mine = 0u;
#pragma unroll
        for (unsigned j = 0; j < 16; ++j) { const unsigned c = xb_ld(&bar[XB_XCNT(j)]); sum += c; cnt += (c > 0u) ? 1u : 0u; mine = (j == x) ? c : mine; }
        if (sum == G) break;
        __builtin_amdgcn_s_sleep(1);
        if ((++sp & 255u) == 0u) { if (xb_ld(&bar[XB_TMO])) break; if (sp > XB_SPIN_CAP) { atomicAdd(&bar[XB_TMO], 1u); break; } }
    }
    nloc = mine > 0u ? mine : 1u; nx = cnt > 0u ? cnt : 1u;
}
__device__ __forceinline__ void xcd_barrier(const XcdBarrier& b) {
    asm volatile("s_waitcnt vmcnt(0)" ::: "memory");
    __syncthreads();
    if (threadIdx.x == 0) {
        unsigned* bar = b.bar;
        __builtin_amdgcn_s_waitcnt(0);
        unsigned nloc = b.st[0], nx = b.st[1];
        if (nloc == 0u) { xcd_barrier_complete(bar, b.x, nloc, nx); b.st[0] = nloc; b.st[1] = nx; }
        const unsigned old = xb_add(&bar[XB_XSUB(b.x)], 1u);
        const unsigned gen = old / nloc;
        if (old + 1u == (gen + 1u) * nloc) {
            __builtin_amdgcn_fence(__ATOMIC_RELEASE, "agent");
            asm volatile("s_waitcnt vmcnt(0)" ::: "memory");
            const unsigned og = xb_add(&bar[XB_TOP], 1u);
            const unsigned tg = og / nx;
            if (og + 1u == (tg + 1u) * nx) xb_add(&bar[XB_TOPGEN], 1u);
            else XB_SPIN(xb_ld(&bar[XB_TOPGEN]) == tg, bar);
            __builtin_amdgcn_fence(__ATOMIC_ACQUIRE, "agent");
            xb_add(&bar[XB_XGEN(b.x)], 1u);
            asm volatile("s_waitcnt vmcnt(0)" ::: "memory");
        } else {
            XB_SPIN(xb_ld(&bar[XB_XGEN(b.x)]) == gen, bar);
            __builtin_amdgcn_fence(__ATOMIC_ACQUIRE, "agent");
            asm volatile("s_waitcnt vmcnt(0)" ::: "memory");
        }
    }
    __syncthreads();
}

__device__ __forceinline__ float wave_sum(float v) {
#pragma unroll
    for (int o = 1; o < 64; o <<= 1) v += __shfl_xor(v, o);
    return v;
}
__device__ __forceinline__ int t5_bucket(int n) {
    n = n < 0 ? 0 : n;
    if (n < 16) return n;
    const int e = 31 - __clz(n);
    const unsigned nn = (unsigned)n * (unsigned)n;
    const int f = 2 * e + ((nn >> (2 * e + 1)) ? 1 : 0);
    const int b = f + 8;
    return b > 31 ? 31 : b;
}
__device__ __forceinline__ void load_row_bf16(float (&q)[64], const bf16* p) {
    const v4u* p4 = (const v4u*)p;
#pragma unroll
    for (int c = 0; c < 8; ++c) { const v4u w = p4[c];
        q[8 * c + 0] = bf_lo(w.x); q[8 * c + 1] = bf_hi(w.x); q[8 * c + 2] = bf_lo(w.y); q[8 * c + 3] = bf_hi(w.y);
        q[8 * c + 4] = bf_lo(w.z); q[8 * c + 5] = bf_hi(w.z); q[8 * c + 6] = bf_lo(w.w); q[8 * c + 7] = bf_hi(w.w); }
}
__device__ __forceinline__ float dot64(const float (&q)[64], const bf16* p) {
    const v4u* p4 = (const v4u*)p; float s0 = 0.f, s1 = 0.f;
#pragma unroll
    for (int c = 0; c < 8; ++c) { const v4u w = p4[c];
        s0 = fmaf(q[8 * c + 0], bf_lo(w.x), s0); s1 = fmaf(q[8 * c + 1], bf_hi(w.x), s1); s0 = fmaf(q[8 * c + 2], bf_lo(w.y), s0); s1 = fmaf(q[8 * c + 3], bf_hi(w.y), s1);
        s0 = fmaf(q[8 * c + 4], bf_lo(w.z), s0); s1 = fmaf(q[8 * c + 5], bf_hi(w.z), s1); s0 = fmaf(q[8 * c + 6], bf_lo(w.w), s0); s1 = fmaf(q[8 * c + 7], bf_hi(w.w), s1); }
    return s0 + s1;
}
__device__ __forceinline__ void axpy64(float (&acc)[64], float p, const bf16* vp) {
    const v4u* p4 = (const v4u*)vp;
#pragma unroll
    for (int c = 0; c < 8; ++c) { const v4u w = p4[c];
        acc[8 * c + 0] = fmaf(p, bf_lo(w.x), acc[8 * c + 0]); acc[8 * c + 1] = fmaf(p, bf_hi(w.x), acc[8 * c + 1]); acc[8 * c + 2] = fmaf(p, bf_lo(w.y), acc[8 * c + 2]); acc[8 * c + 3] = fmaf(p, bf_hi(w.y), acc[8 * c + 3]);
        acc[8 * c + 4] = fmaf(p, bf_lo(w.z), acc[8 * c + 4]); acc[8 * c + 5] = fmaf(p, bf_hi(w.z), acc[8 * c + 5]); acc[8 * c + 6] = fmaf(p, bf_lo(w.w), acc[8 * c + 6]); acc[8 * c + 7] = fmaf(p, bf_hi(w.w), acc[8 * c + 7]); }
}
__device__ __forceinline__ float dot64f(const float (&q)[64], const float* p) {
    const f32x4* p4 = (const f32x4*)p; float s0 = 0.f, s1 = 0.f;
#pragma unroll
    for (int c = 0; c < 16; ++c) { const f32x4 w = p4[c]; s0 = fmaf(q[4 * c + 0], w.x, s0); s1 = fmaf(q[4 * c + 1], w.y, s1); s0 = fmaf(q[4 * c + 2], w.z, s0); s1 = fmaf(q[4 * c + 3], w.w, s1); }
    return s0 + s1;
}
__device__ __forceinline__ void axpy64f(float (&acc)[64], float p, const float* vp) {
    const f32x4* p4 = (const f32x4*)vp;
#pragma unroll
    for (int c = 0; c < 16; ++c) { const f32x4 w = p4[c]; acc[4 * c + 0] = fmaf(p, w.x, acc[4 * c + 0]); acc[4 * c + 1] = fmaf(p, w.y, acc[4 * c + 1]); acc[4 * c + 2] = fmaf(p, w.z, acc[4 * c + 2]); acc[4 * c + 3] = fmaf(p, w.w, acc[4 * c + 3]); }
}
__device__ __forceinline__ void store_row_f32(float* o, const float (&acc)[64], float sc) {
    f32x4* o4 = (f32x4*)o;
#pragma unroll
    for (int c = 0; c < 16; ++c) o4[c] = (f32x4){acc[4 * c] * sc, acc[4 * c + 1] * sc, acc[4 * c + 2] * sc, acc[4 * c + 3] * sc};
}
__device__ __forceinline__ void rms_row_to_bf16(const float* xrow, const float* g, bf16* orow, int lane) {
    const f32x4* xr = (const f32x4*)xrow + lane; f32x4 v[4]; float s = 0.f;
#pragma unroll
    for (int j = 0; j < 4; ++j) { v[j] = xr[64 * j]; s += (v[j].x * v[j].x + v[j].y * v[j].y) + (v[j].z * v[j].z + v[j].w * v[j].w); }
    const float rstd = rsqrtf(wave_sum(s) * (1.f / DM) + RMS_EPS);
    const f32x4* gr = (const f32x4*)g + lane; v2u* o8 = (v2u*)orow + lane;
#pragma unroll
    for (int j = 0; j < 4; ++j) { const f32x4 gv = gr[64 * j]; v2u w; w.x = pk2(v[j].x * rstd * gv.x, v[j].y * rstd * gv.y); w.y = pk2(v[j].z * rstd * gv.z, v[j].w * rstd * gv.w); o8[64 * j] = w; }
}

struct Args { const float* in[17]; float* out; unsigned char* ws; int ph_lo, ph_hi, li, pad; };
enum { I_X = 0, I_RELB, I_LNAP, I_WIN, I_POS, I_W1, I_B1, I_W2, I_SINK, I_GRPG, I_WOUT, I_LNAPOST, I_LNFP, I_WG, I_WU, I_WD, I_LNFPOST };

__device__ __forceinline__ void p0_prologue(const Args& a, LAS unsigned char* lds, int tid, int lane, int wave) {
    unsigned char* ws = a.ws;
    LAS float* tile = (LAS float*)lds;
    for (int it = blockIdx.x; it < 6400; it += gridDim.x) {
        const int l = it / 3200; int r = it % 3200;
        const int nl = tid & 63;
        const float* W; int ldw, Kd, kt, nt, col; bf16* dst;
        if (r < 576) { kt = r / 36; nt = r % 36; const int n = nt * 64 + nl; W = a.in[I_WIN] + (size_t)l * DM * INW; ldw = INW; Kd = DM;
            col = n < 640 ? n : (n < 2176 ? n + 12 : (n < 2188 ? n - 2176 + 640 : -1)); dst = (bf16*)(ws + WS_WIN) + (size_t)l * INP * DM; }
        else if (r < 832) { r -= 576; kt = r / 16; nt = r % 16; W = a.in[I_WOUT] + (size_t)l * DM * DM; ldw = DM; Kd = DM; col = nt * 64 + nl; dst = (bf16*)(ws + WS_WOUT) + (size_t)l * DM * DM; }
        else if (r < 2240) { r -= 832; kt = r / 88; nt = r % 88; const int n = nt * 64 + nl, t = n >> 7; W = ((t & 1) ? a.in[I_WU] : a.in[I_WG]) + (size_t)l * DM * DFF; ldw = DFF; Kd = DM;
            col = (t >> 1) * 128 + (n & 127); dst = (bf16*)(ws + WS_WGU) + (size_t)l * NGU * DM; }
        else if (r < 2944) { r -= 2240; kt = r / 16; nt = r % 16; W = a.in[I_WD] + (size_t)l * DFF * DM; ldw = DM; Kd = DFF; col = nt * 64 + nl; dst = (bf16*)(ws + WS_WDN) + (size_t)l * DM * DFF; }
        else { r -= 2944; const int kv = r / 128; r %= 128; kt = r / 4; nt = r % 4; W = a.in[I_W1] + (size_t)(l * 2 + kv) * 2048 * 256; ldw = 256; Kd = 2048; col = nt * 64 + nl;
            dst = (bf16*)(ws + WS_W1) + (size_t)(l * 2 + kv) * 256 * 2048; }
#pragma unroll
        for (int i = 0; i < 8; ++i) { const int k = i * 8 + (tid >> 6); tile[k * 65 + nl] = col >= 0 ? W[(size_t)(kt * 64 + k) * ldw + col] : 0.f; }
        __syncthreads();
        { const int rr = tid >> 3, c = tid & 7; const LAS float* s = tile + (8 * c) * 65 + rr;
          v4u o; o.x = pk2(s[0 * 65], s[1 * 65]); o.y = pk2(s[2 * 65], s[3 * 65]); o.z = pk2(s[4 * 65], s[5 * 65]); o.w = pk2(s[6 * 65], s[7 * 65]);
          *(v4u*)(dst + (size_t)(nt * 64 + rr) * Kd + kt * 64 + 8 * c) = o; }
        __syncthreads();
    }
    const int gw = blockIdx.x * NWAVES + wave, NGW = gridDim.x * NWAVES;
    for (int o = gw; o < DEPTH * 2 * 256; o += NGW) { const int lk = o >> 8, n = o & 255; float s = 0.f;
        const float* pos = a.in[I_POS] + (size_t)lk * 2048; const float* w1 = a.in[I_W1] + (size_t)lk * 2048 * 256 + n;
#pragma unroll 8
        for (int i = 0; i < 32; ++i) { const int k = lane + 64 * i; s = fmaf(pos[k], w1[(size_t)k * 256], s); }
        s = wave_sum(s);
        if (lane == 0) ((float*)(ws + WS_POSB))[o] = s + a.in[I_B1][o]; }
    for (int i = blockIdx.x * NWAVES * 64 + tid; i < DEPTH * 2 * 64 * 256; i += gridDim.x * NWAVES * 64) { const int n = i & 255, d = (i >> 8) & 63, lk = i >> 14;
        ((bf16*)(ws + WS_W2T))[i] = (bf16)f2bf(a.in[I_W2][((size_t)lk * 256 + n) * 64 + d]); }
    for (int m = gw; m < M; m += NGW) rms_row_to_bf16(a.in[I_X] + (size_t)m * DM, a.in[I_LNAP], (bf16*)(ws + WS_XN) + (size_t)m * DM, lane);
}

namespace fa {
#define FA_BAR() do { asm volatile("s_waitcnt lgkmcnt(0)" ::: "memory"); __builtin_amdgcn_s_barrier(); asm volatile("" ::: "memory"); } while (0)
typedef short bf16x8 __attribute__((ext_vector_type(8)));
typedef float f32x16 __attribute__((ext_vector_type(16)));
typedef short s16x4 __attribute__((ext_vector_type(4)));
constexpr int KP = 144;
constexpr int L_K = 0, L_V = 64 * KP, L_TAB = L_V + 8192;
constexpr float LOG2E = 1.4426950408889634f;
constexpr float C2 = 0.125f * LOG2E;
__device__ __forceinline__ int crow(int r, int hi) { return (r & 3) + 8 * (r >> 2) + 4 * hi; }
typedef float f32x2_t __attribute__((ext_vector_type(2))); typedef __bf16 bf16x2_t __attribute__((ext_vector_type(2)));
__device__ __forceinline__ unsigned cvtpk(float lo, float hi) { f32x2_t v = {lo, hi}; bf16x2_t b = __builtin_convertvector(v, bf16x2_t); return __builtin_bit_cast(unsigned, b); }
__device__ __forceinline__ float swap32(float v) { const unsigned u = __float_as_uint(v); auto rr = __builtin_amdgcn_permlane32_swap(u, u, false, false); return __uint_as_float(rr[0] == u ? rr[1] : rr[0]); }
struct Stage { v4u k, v; };
__device__ __forceinline__ void stage_load(Stage& s, const bf16* Kg, const bf16* Vg, size_t ldk, size_t ldv, int tid) {
    const int key = tid >> 3, ch = tid & 7;
    s.k = *(const v4u*)(Kg + (size_t)key * ldk + ch * 8); s.v = *(const v4u*)(Vg + (size_t)key * ldv + ch * 8);
}
__device__ __forceinline__ void stage_store(const Stage& s, LAS unsigned char* lds, int tid) {
    const int key = tid >> 3, ch = tid & 7;
    *(LAS v4u*)(lds + L_K + key * KP + ch * 16) = s.k;
    *(LAS v4u*)(lds + L_V + (ch >> 2) * 4096 + key * 64 + (ch & 3) * 16) = s.v;
}
__device__ __forceinline__ void load_q(bf16x8 (&qf)[4], const bf16* qrow, int hi) {
#pragma unroll
    for (int s = 0; s < 4; ++s) qf[s] = *(const bf16x8*)(qrow + 16 * s + 8 * hi);
}
__device__ __forceinline__ void qk_tile(f32x16& p0, f32x16& p1, const LAS unsigned char* lds, const bf16x8 (&qf)[4], int lane) {
    const LAS unsigned char* kb = lds + L_K + (lane & 31) * KP + (lane >> 5) * 16;
#pragma unroll
    for (int r = 0; r < 16; ++r) { p0[r] = 0.f; p1[r] = 0.f; }
#pragma unroll
    for (int s = 0; s < 4; ++s) {
        const bf16x8 a0 = *(const LAS bf16x8*)(kb + s * 32), a1 = *(const LAS bf16x8*)(kb + 32 * KP + s * 32);
        p0 = __builtin_amdgcn_mfma_f32_32x32x16_bf16(a0, qf[s], p0, 0, 0, 0); p1 = __builtin_amdgcn_mfma_f32_32x32x16_bf16(a1, qf[s], p1, 0, 0, 0);
    }
}
__device__ __forceinline__ s16x4 vtr(const LAS unsigned char* p) { return __builtin_bit_cast(s16x4, __builtin_amdgcn_ds_read_tr16_b64_v4i16((LAS s16x4*)p)); }
__device__ __forceinline__ void pv_tile(f32x16& o0, f32x16& o1, const LAS unsigned char* lds, const f32x16& p0, const f32x16& p1, int lane) {
    const int hi = lane >> 5;
    const LAS unsigned char* vb = lds + L_V + ((lane & 15) >> 2) * 64 + (((lane >> 4) & 1) * 16 + (lane & 3) * 4) * 2 + (4 * hi) * 64;
#pragma unroll
    for (int ks = 0; ks < 4; ++ks) {
        const f32x16& p = ks < 2 ? p0 : p1; const int b = 8 * (ks & 1);
        v4u pw; pw.x = cvtpk(p[b + 0], p[b + 1]); pw.y = cvtpk(p[b + 2], p[b + 3]); pw.z = cvtpk(p[b + 4], p[b + 5]); pw.w = cvtpk(p[b + 6], p[b + 7]);
        const bf16x8 pb = __builtin_bit_cast(bf16x8, pw);
#pragma unroll
        for (int dt = 0; dt < 2; ++dt) {
            const s16x4 lo = vtr(vb + dt * 4096 + (16 * ks) * 64), hh = vtr(vb + dt * 4096 + (16 * ks + 8) * 64);
            const bf16x8 a = (bf16x8){lo[0], lo[1], lo[2], lo[3], hh[0], hh[1], hh[2], hh[3]};
            if (dt == 0) o0 = __builtin_amdgcn_mfma_f32_32x32x16_bf16(a, pb, o0, 0, 0, 0); else o1 = __builtin_amdgcn_mfma_f32_32x32x16_bf16(a, pb, o1, 0, 0, 0);
        }
    }
}
__device__ __forceinline__ void softmax_step(f32x16& p0, f32x16& p1, float& m, float& l, f32x16& o0, f32x16& o1) {
    float tm = fmaxf(p0[0], p1[0]);
#pragma unroll
    for (int r = 1; r < 16; ++r) tm = fmaxf(tm, fmaxf(p0[r], p1[r]));
    tm = fmaxf(tm, swap32(tm));
    if (__any(tm > m)) { const float mn = fmaxf(m, tm), sc = __builtin_amdgcn_exp2f(m - mn); m = mn; l *= sc;
#pragma unroll
        for (int r = 0; r < 16; ++r) { o0[r] *= sc; o1[r] *= sc; } }
    float s = 0.f;
#pragma unroll
    for (int r = 0; r < 16; ++r) { p0[r] = __builtin_amdgcn_exp2f(p0[r] - m); p1[r] = __builtin_amdgcn_exp2f(p1[r] - m); s += p0[r] + p1[r]; }
    l += s;
}
__device__ __forceinline__ void store_ot(bf16* orow, const f32x16& o0, const f32x16& o1, float sc, int hi) {
#pragma unroll
    for (int g = 0; g < 4; ++g) {
        v2u w; w.x = cvtpk(o0[4 * g] * sc, o0[4 * g + 1] * sc); w.y = cvtpk(o0[4 * g + 2] * sc, o0[4 * g + 3] * sc); *(v2u*)(orow + 8 * g + 4 * hi) = w;
        w.x = cvtpk(o1[4 * g] * sc, o1[4 * g + 1] * sc); w.y = cvtpk(o1[4 * g + 2] * sc, o1[4 * g + 3] * sc); *(v2u*)(orow + 32 + 8 * g + 4 * hi) = w;
    }
}

template <int WIN, bool SINK>
__device__ __forceinline__ void band_unit(LAS unsigned char* lds, const bf16* PROJ, const float* relb, int tok0, int cq, int ck, int cv, int bh0, const float* sinks, bf16* out, int old, int ocol0, int tid, int lane, int wave) {
    constexpr int TW = WIN + 128;
    LAS float* bd = (LAS float*)(lds + L_TAB);
    FA_BAR();
    for (int i = tid; i < 4 * TW; i += NWAVES * 64) { const int hl = i / TW, dist = i % TW - 64;
        bd[i] = (dist < 0 || dist >= WIN) ? -INFINITY : relb[t5_bucket(dist) * 12 + bh0 + hl] * LOG2E; }
    const int hl = wave >> 1, hi = lane >> 5, q32 = lane & 31;
    const int t0 = tok0 & (SEQ - 1); const size_t rb = (size_t)(tok0 - t0);
    const int tq = tok0 + 32 * (wave & 1) + q32, t = tq & (SEQ - 1);
    bf16x8 qf[4]; load_q(qf, PROJ + (size_t)tq * INP + cq + hl * 64, hi);
    f32x16 o0, o1;
#pragma unroll
    for (int r = 0; r < 16; ++r) { o0[r] = 0.f; o1[r] = 0.f; }
    float m = -1e30f, l = 0.f;
    if (SINK) { m = sinks[hl] * LOG2E; l = hi == 0 ? 1.f : 0.f; }
    const int kt_hi = t0 >> 6, kt_lo = (t0 - WIN > 0 ? t0 - WIN : 0) >> 6;
    Stage st; stage_load(st, PROJ + (rb + (size_t)kt_hi * 64) * INP + ck, PROJ + (rb + (size_t)kt_hi * 64) * INP + cv, INP, INP, tid);
    const LAS float* bdh = bd + hl * TW;
    for (int kt = kt_hi; kt >= kt_lo; --kt) {
        FA_BAR();
        stage_store(st, lds, tid);
        FA_BAR();
        if (kt > kt_lo) stage_load(st, PROJ + (rb + (size_t)(kt - 1) * 64) * INP + ck, PROJ + (rb + (size_t)(kt - 1) * 64) * INP + cv, INP, INP, tid);
        f32x16 p0, p1; qk_tile(p0, p1, lds, qf, lane);
        const LAS float* bp = bdh + (t - kt * 64 + 64 - 63);
#pragma unroll
        for (int r = 0; r < 16; ++r) { p0[r] = fmaf(p0[r], C2, bp[63 - crow(r, hi)]); p1[r] = fmaf(p1[r], C2, bp[63 - 32 - crow(r, hi)]); }
        softmax_step(p0, p1, m, l, o0, o1);
        pv_tile(o0, o1, lds, p0, p1, lane);
    }
    l += swap32(l);
    store_ot(out + (size_t)tq * old + ocol0 + hl * 64, o0, o1, 1.f / l, hi);
}

__device__ __forceinline__ void stat_step(const f32x16& p0, const f32x16& p1, float& m, float& l) {
    float tm = fmaxf(p0[0], p1[0]);
#pragma unroll
    for (int r = 1; r < 16; ++r) tm = fmaxf(tm, fmaxf(p0[r], p1[r]));
    tm = fmaxf(tm, swap32(tm));
    const float mn = fmaxf(m, tm); l *= __builtin_amdgcn_exp2f(m - mn); m = mn;
    float s = 0.f;
#pragma unroll
    for (int r = 0; r < 16; ++r) s += __builtin_amdgcn_exp2f(p0[r] - m) + __builtin_amdgcn_exp2f(p1[r] - m);
    l += s;
}
constexpr int L_IDX = 90112;
constexpr int L_IMP = L_TAB + 1024, IMP_P = 257;
constexpr float IMP_SCALE = 134217728.f;
__device__ __forceinline__ void cmp_unit(LAS unsigned char* lds, const bf16* PROJ, const bf16* KCB, const bf16* VCB, const float* relb, int tok0, bf16* OCMP, int tid, int lane, int wave) {
    LAS float* tabl = (LAS float*)(lds + L_TAB); LAS unsigned* imp = (LAS unsigned*)(lds + L_IMP);
    FA_BAR();
    if (tid < 128) tabl[tid] = relb[(tid & 31) * 12 + (tid >> 5)] * LOG2E;
    for (int i = tid; i < 64 * IMP_P; i += NWAVES * 64) imp[i] = 0u;
    const int hl = wave >> 1, hi = lane >> 5, q32 = lane & 31;
    const int t0 = tok0 & (SEQ - 1), b = tok0 >> 14;
    const int tql = 32 * (wave & 1) + q32, tq = tok0 + tql, t = tq & (SEQ - 1);
    bf16x8 qf[4]; load_q(qf, PROJ + (size_t)tq * INP + C_NQ + hl * 64, hi);
    const int nc_unit = ((t0 + 63 - 31) >> 4) + 1, ntile = (nc_unit + 63) >> 6;
    const bf16* kcb = KCB + (size_t)b * NCP * 64; const bf16* vcb = VCB + (size_t)b * NCP * 64;
    const LAS float* th = tabl + hl * 32;
    float m = -1e30f, l = 0.f;
    f32x16 o0, o1;
#pragma unroll
    for (int r = 0; r < 16; ++r) { o0[r] = 0.f; o1[r] = 0.f; }
    float inv = 0.f;
    for (int pass = 0; pass < 2; ++pass) {
        Stage st; stage_load(st, kcb, vcb, 64, 64, tid);
        for (int ct = 0; ct < ntile; ++ct) {
            FA_BAR();
            stage_store(st, lds, tid);
            FA_BAR();
            if (ct + 1 < ntile) stage_load(st, kcb + (size_t)(ct + 1) * 64 * 64, vcb + (size_t)(ct + 1) * 64 * 64, 64, 64, tid);
            f32x16 p0, p1; qk_tile(p0, p1, lds, qf, lane);
            const int dbase = t - 31 - 1024 * ct;
            if (t0 + 32 * (wave & 1) - 31 - 1024 * ct - 1008 >= 2897) {
                const float b31 = th[31];
#pragma unroll
                for (int r = 0; r < 16; ++r) { p0[r] = fmaf(p0[r], C2, b31); p1[r] = fmaf(p1[r], C2, b31); }
            } else {
#pragma unroll
                for (int r = 0; r < 16; ++r) { const int d0 = dbase - 16 * crow(r, hi), d1 = d0 - 512;
                    p0[r] = d0 >= 0 ? fmaf(p0[r], C2, th[t5_bucket(d0)]) : -INFINITY; p1[r] = d1 >= 0 ? fmaf(p1[r], C2, th[t5_bucket(d1)]) : -INFINITY; }
            }
            if (pass == 0) { stat_step(p0, p1, m, l); }
            else {
#pragma unroll
                for (int r = 0; r < 16; ++r) { p0[r] = __builtin_amdgcn_exp2f(p0[r] - m) * inv; p1[r] = __builtin_amdgcn_exp2f(p1[r] - m) * inv; }
                pv_tile(o0, o1, lds, p0, p1, lane);
                LAS unsigned* ir = imp + tql * IMP_P + 16 * ct + hi;
#pragma unroll
                for (int g = 0; g < 4; ++g) {
                    { const float A = (p0[4 * g] + p0[4 * g + 1]) + (p0[4 * g + 2] + 0.5f * p0[4 * g + 3]), Cc = 0.5f * p0[4 * g + 3];
                      __hip_atomic_fetch_add(ir + 2 * g, (unsigned)(A * IMP_SCALE + 0.5f), __ATOMIC_RELAXED, __HIP_MEMORY_SCOPE_WORKGROUP); __hip_atomic_fetch_add(ir + 2 * g + 1, (unsigned)(Cc * IMP_SCALE + 0.5f), __ATOMIC_RELAXED, __HIP_MEMORY_SCOPE_WORKGROUP); }
                    { const float A = (p1[4 * g] + p1[4 * g + 1]) + (p1[4 * g + 2] + 0.5f * p1[4 * g + 3]), Cc = 0.5f * p1[4 * g + 3];
                      __hip_atomic_fetch_add(ir + 8 + 2 * g, (unsigned)(A * IMP_SCALE + 0.5f), __ATOMIC_RELAXED, __HIP_MEMORY_SCOPE_WORKGROUP); __hip_atomic_fetch_add(ir + 8 + 2 * g + 1, (unsigned)(Cc * IMP_SCALE + 0.5f), __ATOMIC_RELAXED, __HIP_MEMORY_SCOPE_WORKGROUP); }
                }
            }
        }
        if (pass == 0) { const float lt = l + swap32(l); inv = lt > 0.f ? 1.f / lt : 0.f; }
    }
    store_ot(OCMP + (size_t)tq * 256 + hl * 64, o0, o1, 1.f, hi);
    FA_BAR();
    for (int k = 0; k < 8; ++k) {
        const int tl = wave * 8 + k, tt = t0 + tl, cur = tt >> 6;
        int my = -1;
        if (cur <= 15) { my = lane <= cur ? lane : -1; }
        else {
            int v[4];
#pragma unroll
            for (int i = 0; i < 4; ++i) { const int j = lane + 64 * i; v[i] = (j >= 1 && j <= cur - 2) ? (int)imp[tl * IMP_P + j] : -1; }
            if (lane == 0) my = 0; else if (lane == 1) my = cur - 1; else if (lane == 2) my = cur;
            for (int r = 0; r < 13; ++r) {
                int bv = v[0], bj = lane;
#pragma unroll
                for (int i = 1; i < 4; ++i) if (v[i] > bv) { bv = v[i]; bj = lane + 64 * i; }
#pragma unroll
                for (int o = 1; o < 64; o <<= 1) { const int ov = __shfl_xor(bv, o), oj = __shfl_xor(bj, o); if (ov > bv || (ov == bv && oj < bj)) { bv = ov; bj = oj; } }
                if (lane == 3 + r) my = bj;
#pragma unroll
                for (int i = 0; i < 4; ++i) if (lane + 64 * i == bj) v[i] = -1;
            }
        }
        if (lane < 16) ((LAS int*)(lds + L_IDX))[tl * 16 + lane] = my;
    }
}

__device__ __forceinline__ void sb_unit(LAS unsigned char* lds, const bf16* PROJ, int tok0, int h, bf16* OSB, int tid, int lane, int wave) {
    LAS int* flags = (LAS int*)(lds + L_TAB);
    FA_BAR();
    if (tid < 8) flags[tid] = 0;
    const int hi = lane >> 5, q32 = lane & 31;
    const int t0 = tok0 & (SEQ - 1); const size_t rb = (size_t)(tok0 - t0);
    const int tq = tok0 + 32 * wave + q32, t = tq & (SEQ - 1);
    bf16x8 qf[4]; load_q(qf, PROJ + (size_t)tq * INP + C_BQ + h * 64, hi);
    f32x16 o0, o1;
#pragma unroll
    for (int r = 0; r < 16; ++r) { o0[r] = 0.f; o1[r] = 0.f; }
    float carry = 0.f; bool done = false;
    const int kt_hi = (t0 >> 6) + 3, kt_w = (t0 + 32 * wave + 31) >> 6;
    const int ck = C_BK + h * 64, cv = C_BV + h * 64;
    Stage st; stage_load(st, PROJ + (rb + (size_t)kt_hi * 64) * INP + ck, PROJ + (rb + (size_t)kt_hi * 64) * INP + cv, INP, INP, tid);
    for (int kt = kt_hi; kt >= 0; --kt) {
        FA_BAR();
        stage_store(st, lds, tid);
        if (lane == 0) flags[wave] = done ? 1 : 0;
        FA_BAR();
        { int alld = 1;
#pragma unroll
          for (int w = 0; w < 8; ++w) alld &= flags[w];
          if (alld) break; }
        if (kt > 0) stage_load(st, PROJ + (rb + (size_t)(kt - 1) * 64) * INP + ck, PROJ + (rb + (size_t)(kt - 1) * 64) * INP + cv, INP, INP, tid);
        if (!done && kt <= kt_w) {
            f32x16 p0, p1; qk_tile(p0, p1, lds, qf, lane);
            const int kb = t - kt * 64;
#pragma unroll
            for (int half = 1; half >= 0; --half) {
                f32x16& p = half ? p1 : p0; float T[4], U[4];
                float ln[16];
#pragma unroll
                for (int r = 0; r < 16; ++r) { const float z = p[r] * 0.125f; const bool valid = (32 * half + crow(r, hi)) < kb;
                    const float sp = fmaxf(z, 0.f) + __logf(1.f + __expf(-fabsf(z)));
                    ln[r] = valid ? -sp : 0.f; p[r] = valid ? z - sp : -INFINITY; }
#pragma unroll
                for (int g = 0; g < 4; ++g) { T[g] = (ln[4 * g] + ln[4 * g + 1]) + (ln[4 * g + 2] + ln[4 * g + 3]); U[g] = swap32(T[g]); }
                float suf = carry;
#pragma unroll
                for (int g = 3; g >= 0; --g) {
                    float off = suf + (hi == 0 ? U[g] : 0.f);
                    const float l3 = off, l2 = l3 + ln[4 * g + 3], l1 = l2 + ln[4 * g + 2], l0 = l1 + ln[4 * g + 1];
                    p[4 * g + 3] = __expf(p[4 * g + 3] + l3); p[4 * g + 2] = __expf(p[4 * g + 2] + l2); p[4 * g + 1] = __expf(p[4 * g + 1] + l1); p[4 * g] = __expf(p[4 * g] + l0);
                    suf += T[g] + U[g];
                }
                carry = suf;
            }
            pv_tile(o0, o1, lds, p0, p1, lane);
            if (__all(carry < -104.f)) done = true;
        }
    }
    store_ot(OSB + (size_t)tq * 256 + h * 64, o0, o1, 1.f, hi);
}
}

namespace fa {
typedef float f32x4v __attribute__((ext_vector_type(4)));
constexpr float SL_THR_L2 = 8.f;
constexpr int SL_NB = 4, SL_TILE = L_TAB  , SL_SEL = SL_NB * SL_TILE, SL_TABN = SL_SEL + 256 * 8, SL_TABB = SL_TABN + 4 * 384 * 4, SL_THR = SL_TABB + 4 * 32 * 4, SL_END = SL_THR + 32 * 4;
template <int NG>
__device__ __forceinline__ void slc_unit(LAS unsigned char* lds, const bf16* PROJ, const float* relb, int tok0, bf16* OSLC, int tid, int lane, int wave) {
    constexpr int TOKW = 4 * NG, TOKU = 8 * TOKW, SW = 2;
    static_assert(TOKU <= 64, "selection mask is 64 bits per block");
    LAS unsigned* selm = (LAS unsigned*)(lds + SL_SEL); LAS float* tabn = (LAS float*)(lds + SL_TABN); LAS float* tabb = (LAS float*)(lds + SL_TABB); LAS int* thrb = (LAS int*)(lds + SL_THR);
    FA_BAR();
    for (int i = tid; i < 256 * SW; i += NWAVES * 64) selm[i] = 0u;
    for (int i = tid; i < 4 * 384; i += NWAVES * 64) { const int h = i / 384, dist = i % 384 - 64; tabn[i] = dist < 0 ? -INFINITY : relb[t5_bucket(dist) * 12 + h] * LOG2E; }
    if (tid < 128) tabb[tid] = relb[(tid & 31) * 12 + (tid >> 5)] * LOG2E;
    if (tid < 32) { int v = 0;
        const int T[15] = {23, 32, 46, 64, 91, 128, 182, 256, 363, 512, 725, 1024, 1449, 2048, 2897};
#pragma unroll
        for (int k = 0; k < 15; ++k) if (tid == 17 + k) v = T[k];
        thrb[tid] = v; }
    FA_BAR();
    for (int i = tid; i < TOKU * 16; i += NWAVES * 64) { const int tl = i >> 4, j = ((const LAS int*)(lds + L_IDX))[i];
        if (j >= 0) __hip_atomic_fetch_or(selm + j * SW + (tl >> 5), 1u << (tl & 31), __ATOMIC_RELAXED, __HIP_MEMORY_SCOPE_WORKGROUP); }
    const int col = lane & 15, rg = lane >> 4, head = col & 3;
    const int t0 = tok0 & (SEQ - 1); const size_t rb = (size_t)(tok0 - t0);
    const int cur = t0 >> 6;
    bf16x8 qf[NG][2]; int tt[NG];
    f32x4v o[NG][4]; float m[NG], l[NG];
#pragma unroll
    for (int gi = 0; gi < NG; ++gi) { const int tq = tok0 + TOKW * wave + 4 * gi + (col >> 2); tt[gi] = tq & (SEQ - 1);
        const bf16* qrow = PROJ + (size_t)tq * INP + C_NQ + head * 64;
        qf[gi][0] = *(const bf16x8*)(qrow + 8 * rg); qf[gi][1] = *(const bf16x8*)(qrow + 32 + 8 * rg);
        m[gi] = -1e30f; l[gi] = 0.f;
#pragma unroll
        for (int dt = 0; dt < 4; ++dt) o[gi][dt] = (f32x4v){0.f, 0.f, 0.f, 0.f}; }
    Stage st[4];
#pragma unroll
    for (int u = 0; u < 4; ++u) if (u <= cur) stage_load(st[u], PROJ + (rb + (size_t)u * 64) * INP + C_KS, PROJ + (rb + (size_t)u * 64) * INP + C_VS, INP, INP, tid);
    const LAS unsigned char* kbp0 = lds + L_K + col * KP + rg * 16;
    const LAS unsigned char* vbp0 = lds + L_V + (4 * rg + (col >> 2)) * 64 + (col & 3) * 8;
    for (int j0 = 0; j0 <= cur; j0 += 4) {
      FA_BAR();
#pragma unroll
      for (int u = 0; u < 4; ++u) if (j0 + u <= cur) stage_store(st[u], lds + u * SL_TILE, tid);
      FA_BAR();
#pragma unroll
      for (int u = 0; u < 4; ++u) if (j0 + 4 + u <= cur) stage_load(st[u], PROJ + (rb + (size_t)(j0 + 4 + u) * 64) * INP + C_KS, PROJ + (rb + (size_t)(j0 + 4 + u) * 64) * INP + C_VS, INP, INP, tid);
#pragma unroll
      for (int u = 0; u < 4; ++u) {
        const int j = j0 + u;
        if (j > cur) break;
        const LAS unsigned char* kbp = kbp0 + u * SL_TILE; const LAS unsigned char* vbp = vbp0 + u * SL_TILE;
        const unsigned wb = (selm[j * SW + ((TOKW * wave) >> 5)] >> ((TOKW * wave) & 31)) & ((1u << TOKW) - 1u);
        if (wb == 0u) continue;
        bf16x8 kf[4][2];
#pragma unroll
        for (int kt = 0; kt < 4; ++kt) { kf[kt][0] = *(const LAS bf16x8*)(kbp + kt * 16 * KP); kf[kt][1] = *(const LAS bf16x8*)(kbp + kt * 16 * KP + 64); }
        const bool near = j >= cur - 3;
#pragma unroll
        for (int gi = 0; gi < NG; ++gi) {
            const unsigned gb = (wb >> (4 * gi)) & 15u;
            if (gb == 0u) continue;
            const bool colvalid = (gb >> (col >> 2)) & 1u;
            f32x4v s[4];
#pragma unroll
            for (int kt = 0; kt < 4; ++kt) { s[kt] = (f32x4v){0.f, 0.f, 0.f, 0.f};
                s[kt] = __builtin_amdgcn_mfma_f32_16x16x32_bf16(kf[kt][0], qf[gi][0], s[kt], 0, 0, 0); s[kt] = __builtin_amdgcn_mfma_f32_16x16x32_bf16(kf[kt][1], qf[gi][1], s[kt], 0, 0, 0); }
            const int dmax = tt[gi] - 64 * j;
            float tms = fmaxf(fmaxf(s[0][0], s[0][1]), fmaxf(s[0][2], s[0][3]));
#pragma unroll
            for (int kt = 1; kt < 4; ++kt) tms = fmaxf(tms, fmaxf(fmaxf(s[kt][0], s[kt][1]), fmaxf(s[kt][2], s[kt][3])));
            int bl = 0, bh = 0;
            if (!near) { bl = t5_bucket(dmax - 63); bh = t5_bucket(dmax); }
            const float cvb = colvalid ? 0.f : -INFINITY;
            float sum = 0.f;
            if (!near && __all(bl == bh)) {
                const float b = tabb[head * 32 + bh] + cvb;
                float tm = fmaf(tms, C2, b);
                if (__any(tm > m[gi] + SL_THR_L2)) {
                    tm = fmaxf(tm, __shfl_xor(tm, 16)); tm = fmaxf(tm, __shfl_xor(tm, 32));
                    const float mn = fmaxf(m[gi], tm), sc = __builtin_amdgcn_exp2f(m[gi] - mn); m[gi] = mn; l[gi] *= sc;
#pragma unroll
                    for (int dt = 0; dt < 4; ++dt) o[gi][dt] *= sc; }
                const float bm = b - m[gi];
#pragma unroll
                for (int kt = 0; kt < 4; ++kt)
#pragma unroll
                    for (int r = 0; r < 4; ++r) { s[kt][r] = __builtin_amdgcn_exp2f(fmaf(s[kt][r], C2, bm)); sum += s[kt][r]; }
            } else {
                if (near) {
                    const LAS float* tp = tabn + head * 384 + (dmax + 64 - 4 * rg - 63);
#pragma unroll
                    for (int kt = 0; kt < 4; ++kt)
#pragma unroll
                        for (int r = 0; r < 4; ++r) s[kt][r] = fmaf(s[kt][r], C2, tp[63 - (16 * kt + r)]) + cvb;
                } else {
                    const float blo = tabb[head * 32 + bl] + cvb, bhi = tabb[head * 32 + bh] + cvb;
                    const int klim = dmax - thrb[bh] - 4 * rg;
#pragma unroll
                    for (int kt = 0; kt < 4; ++kt)
#pragma unroll
                        for (int r = 0; r < 4; ++r) s[kt][r] = fmaf(s[kt][r], C2, (klim >= 16 * kt + r) ? bhi : blo);
                }
                float tm = fmaxf(fmaxf(s[0][0], s[0][1]), fmaxf(s[0][2], s[0][3]));
#pragma unroll
                for (int kt = 1; kt < 4; ++kt) tm = fmaxf(tm, fmaxf(fmaxf(s[kt][0], s[kt][1]), fmaxf(s[kt][2], s[kt][3])));
                if (__any(tm > m[gi] + SL_THR_L2)) {
                    tm = fmaxf(tm, __shfl_xor(tm, 16)); tm = fmaxf(tm, __shfl_xor(tm, 32));
                    const float mn = fmaxf(m[gi], tm), sc = __builtin_amdgcn_exp2f(m[gi] - mn); m[gi] = mn; l[gi] *= sc;
#pragma unroll
                    for (int dt = 0; dt < 4; ++dt) o[gi][dt] *= sc; }
#pragma unroll
                for (int kt = 0; kt < 4; ++kt)
#pragma unroll
                    for (int r = 0; r < 4; ++r) { s[kt][r] = __builtin_amdgcn_exp2f(s[kt][r] - m[gi]); sum += s[kt][r]; }
            }
            l[gi] += sum;
#pragma unroll
            for (int ks = 0; ks < 2; ++ks) {
                v4u pw; pw.x = cvtpk(s[2 * ks][0], s[2 * ks][1]); pw.y = cvtpk(s[2 * ks][2], s[2 * ks][3]); pw.z = cvtpk(s[2 * ks + 1][0], s[2 * ks + 1][1]); pw.w = cvtpk(s[2 * ks + 1][2], s[2 * ks + 1][3]);
                const bf16x8 pb = __builtin_bit_cast(bf16x8, pw);
#pragma unroll
                for (int dt = 0; dt < 4; ++dt) {
                    const LAS unsigned char* vp = vbp + (dt >> 1) * 4096 + (dt & 1) * 32 + (32 * ks) * 64;
                    const s16x4 lo = vtr(vp), hh = vtr(vp + 16 * 64);
                    const bf16x8 a = (bf16x8){lo[0], lo[1], lo[2], lo[3], hh[0], hh[1], hh[2], hh[3]};
                    o[gi][dt] = __builtin_amdgcn_mfma_f32_16x16x32_bf16(a, pb, o[gi][dt], 0, 0, 0);
                }
            }
        }
      }
    }
#pragma unroll
    for (int gi = 0; gi < NG; ++gi) {
        float lt = l[gi]; lt += __shfl_xor(lt, 16); lt += __shfl_xor(lt, 32);
        const float inv = 1.f / lt; const int tq = tok0 + TOKW * wave + 4 * gi + (col >> 2);
        bf16* orow = OSLC + (size_t)tq * 256 + head * 64 + 4 * rg;
#pragma unroll
        for (int dt = 0; dt < 4; ++dt) { v2u w; w.x = cvtpk(o[gi][dt][0] * inv, o[gi][dt][1] * inv); w.y = cvtpk(o[gi][dt][2] * inv, o[gi][dt][3] * inv); *(v2u*)(orow + 16 * dt) = w; }
    }
}
}


struct OneUnit { int pm;
    __device__ __forceinline__ bool next(int i, pg8::Unit& u) const { if (i > 0) return false; u.pm = pm; u.pn = 0; return true; }
    __device__ __forceinline__ void a_ready(const pg8::Unit&) const {}
    __device__ __forceinline__ void done(const pg8::Unit&) const {} };
__device__ __forceinline__ void p_mix_a(const Args& a, int l, LAS unsigned char* lds, int tid, int lane, int wave) {
    unsigned char* ws = a.ws; const bf16* PROJ = (const bf16*)(ws + WS_PROJ); const float* relb = a.in[I_RELB];
    constexpr int NCW = 16;
    if ((int)blockIdx.x < NCW) {
        const int kv = blockIdx.x >> 3, pm = blockIdx.x & 7;
        pg8::Gemm g{(const pg8::bf16_t*)PROJ + (kv ? C_VC : C_KC), (const pg8::bf16_t*)(ws + WS_W1) + (size_t)(l * 2 + kv) * 256 * 2048, 2 * NCP, 256, 2048, (size_t)16 * INP * 2, (size_t)INP * 2};
        OneUnit S{pm}; pg8::EpiBf16<2> E{(pg8::bf16_t*)(ws + WS_HIDC) + (size_t)kv * 2 * NCP * 256, 256, (const float*)(ws + WS_POSB) + (l * 2 + kv) * 256};
        pg8::gemm_phase<pg8::EpiBf16<2>, OneUnit, true, true>(lds + RING_OFF, g, S, E);
        VM_WAIT(); __syncthreads();
        { const bf16* hid = (const bf16*)(ws + WS_HIDC) + ((size_t)kv * 2 * NCP + 256 * pm + 32 * wave) * 256; bf16* kvcb = (bf16*)(ws + WS_KVCB) + ((size_t)kv * 2 * NCP + 256 * pm + 32 * wave) * 64;
          const bf16* w2t = (const bf16*)(ws + WS_W2T) + (size_t)(l * 2 + kv) * 64 * 256;
          const int r32 = lane & 31, hi = lane >> 5;
          fa::f32x16 d0, d1;
#pragma unroll
          for (int r = 0; r < 16; ++r) { d0[r] = 0.f; d1[r] = 0.f; }
#pragma unroll 4
          for (int ks = 0; ks < 16; ++ks) {
              const fa::bf16x8 af = *(const fa::bf16x8*)(hid + (size_t)r32 * 256 + 16 * ks + 8 * hi);
              const fa::bf16x8 b0 = *(const fa::bf16x8*)(w2t + (size_t)r32 * 256 + 16 * ks + 8 * hi), b1 = *(const fa::bf16x8*)(w2t + (size_t)(32 + r32) * 256 + 16 * ks + 8 * hi);
              d0 = __builtin_amdgcn_mfma_f32_32x32x16_bf16(af, b0, d0, 0, 0, 0); d1 = __builtin_amdgcn_mfma_f32_32x32x16_bf16(af, b1, d1, 0, 0, 0); }
#pragma unroll
          for (int r = 0; r < 16; ++r) { const int mr = fa::crow(r, hi); const bool pad = ((256 * pm + 32 * wave + mr) & (NCP - 1)) == NCP - 1;
              kvcb[(size_t)mr * 64 + r32] = (bf16)f2bf(pad ? 0.f : d0[r]); kvcb[(size_t)mr * 64 + 32 + r32] = (bf16)f2bf(pad ? 0.f : d1[r]); } }
    } else {
        const int c = (int)blockIdx.x - NCW, S = (int)gridDim.x - NCW;
        for (int n = c; n < 2048; n += S) {
            if (n < 512) fa::band_unit<512, false>(lds, PROJ, relb, n * 64, C_NQ, C_KW, C_VW, 0, nullptr, (bf16*)(ws + WS_OWIN), 256, 0, tid, lane, wave);
            else if (n < 1024) { const int u = n - 512; fa::sb_unit(lds, PROJ, (u >> 2) * 256, u & 3, (bf16*)(ws + WS_OSB), tid, lane, wave); }
            else { const int u = n - 1024, g = u & 1;
                fa::band_unit<128, true>(lds, PROJ, relb, (u >> 1) * 64, C_SQ + g * 256, C_SK + g * 64, C_SV + g * 64, 4 + 4 * g, a.in[I_SINK] + l * 8 + 4 * g, (bf16*)(ws + WS_OSWA), 512, g * 256, tid, lane, wave); }
        }
    }
}
__device__ __forceinline__ void p_mix_b(const Args& a, LAS unsigned char* lds, int tid, int lane, int wave) {
    unsigned char* ws = a.ws; const bf16* PROJ = (const bf16*)(ws + WS_PROJ); const float* relb = a.in[I_RELB]; const int G = gridDim.x;
    for (int u = blockIdx.x; u < M / 64; u += G) {
        const int tok0 = u < 256 ? u * 64 : SEQ + (255 - (u - 256)) * 64;
        { int t1 = tid; asm volatile("" : "+v"(t1));
          fa::cmp_unit(lds, PROJ, (const bf16*)(ws + WS_KVCB), (const bf16*)(ws + WS_KVCB) + 2 * NCP * 64, relb, tok0, (bf16*)(ws + WS_OCMP), t1, t1 & 63, __builtin_amdgcn_readfirstlane(t1 >> 6)); }
        { int t2 = tid; asm volatile("" : "+v"(t2));
          fa::slc_unit<2>(lds, PROJ, relb, tok0, (bf16*)(ws + WS_OSLC), t2, t2 & 63, __builtin_amdgcn_readfirstlane(t2 >> 6)); }
    }
}
__device__ __forceinline__ f32x4 ld4bf(const bf16* p) { const v2u w = *(const v2u*)p; return (f32x4){bf_lo(w.x), bf_hi(w.x), bf_lo(w.y), bf_hi(w.y)}; }
__device__ __forceinline__ void p_groupnorm(const Args& a, int l, int lane, int wave) {
    const bf16* PROJ = (const bf16*)(a.ws + WS_PROJ); bf16* MIX = (bf16*)(a.ws + WS_XN); const float* gg = a.in[I_GRPG] + (size_t)l * DM;
    const int gw = blockIdx.x * NWAVES + wave, NGW = gridDim.x * NWAVES;
    for (int tok = gw; tok < M; tok += NGW) {
        const int hd = lane >> 4; const bf16* gl = PROJ + (size_t)tok * INP + C_NG;
        const float g0 = 1.f / (1.f + __expf(-bf1(gl[hd]))), g1 = 1.f / (1.f + __expf(-bf1(gl[4 + hd]))), g2 = 1.f / (1.f + __expf(-bf1(gl[8 + hd])));
        const f32x4 oc = ld4bf((const bf16*)(a.ws + WS_OCMP) + (size_t)tok * 256 + 4 * lane), os = ld4bf((const bf16*)(a.ws + WS_OSLC) + (size_t)tok * 256 + 4 * lane), ow = ld4bf((const bf16*)(a.ws + WS_OWIN) + (size_t)tok * 256 + 4 * lane);
        const f32x4 v = oc * g0 + os * g1 + ow * g2;
        float rstd = rsqrtf(wave_sum((v.x * v.x + v.y * v.y) + (v.z * v.z + v.w * v.w)) * (1.f / 256.f) + RMS_EPS);
        f32x4 gv = *((const f32x4*)gg + lane);
        v2u w; w.x = pk2(v.x * rstd * gv.x, v.y * rstd * gv.y); w.y = pk2(v.z * rstd * gv.z, v.w * rstd * gv.w);
        *((v2u*)(MIX + (size_t)tok * DM) + lane) = w;
        const f32x4 s0 = ld4bf((const bf16*)(a.ws + WS_OSWA) + (size_t)tok * 512 + 8 * lane), s1 = ld4bf((const bf16*)(a.ws + WS_OSWA) + (size_t)tok * 512 + 8 * lane + 4);
        rstd = rsqrtf(wave_sum(((s0.x * s0.x + s0.y * s0.y) + (s0.z * s0.z + s0.w * s0.w)) + ((s1.x * s1.x + s1.y * s1.y) + (s1.z * s1.z + s1.w * s1.w))) * (1.f / 512.f) + RMS_EPS);
        const f32x4 ga = *((const f32x4*)(gg + 256) + 2 * lane), gb = *((const f32x4*)(gg + 256) + 2 * lane + 1);
        v4u w4; w4.x = pk2(s0.x * rstd * ga.x, s0.y * rstd * ga.y); w4.y = pk2(s0.z * rstd * ga.z, s0.w * rstd * ga.w); w4.z = pk2(s1.x * rstd * gb.x, s1.y * rstd * gb.y); w4.w = pk2(s1.z * rstd * gb.z, s1.w * rstd * gb.w);
        *((v4u*)(MIX + (size_t)tok * DM + 256) + lane) = w4;
        const f32x4 sb = ld4bf((const bf16*)(a.ws + WS_OSB) + (size_t)tok * 256 + 4 * lane);
        rstd = rsqrtf(wave_sum((sb.x * sb.x + sb.y * sb.y) + (sb.z * sb.z + sb.w * sb.w)) * (1.f / 256.f) + RMS_EPS);
        gv = *((const f32x4*)(gg + 768) + lane);
        w.x = pk2(sb.x * rstd * gv.x, sb.y * rstd * gv.y); w.y = pk2(sb.z * rstd * gv.z, sb.w * rstd * gv.w);
        *((v2u*)(MIX + (size_t)tok * DM + 768) + lane) = w;
    }
}
__device__ __forceinline__ void p_postnorm(const Args& a, const float* xold, const float* gpost, const float* gnext, int lane, int wave) {
    const bf16* F = (const bf16*)(a.ws + WS_F); bf16* XN = (bf16*)(a.ws + WS_XN);
    const int gw = blockIdx.x * NWAVES + wave, NGW = gridDim.x * NWAVES;
    v2u fw[4]; f32x4 xo[4];
    if (gw < M) {
#pragma unroll
        for (int j = 0; j < 4; ++j) { fw[j] = *((const v2u*)(F + (size_t)gw * DM) + lane + 64 * j); xo[j] = *((const f32x4*)(xold + (size_t)gw * DM) + lane + 64 * j); } }
    for (int tok = gw; tok < M; tok += NGW) {
        f32x4 f[4], xc[4]; float s = 0.f;
#pragma unroll
        for (int j = 0; j < 4; ++j) { f[j] = (f32x4){bf_lo(fw[j].x), bf_hi(fw[j].x), bf_lo(fw[j].y), bf_hi(fw[j].y)}; xc[j] = xo[j];
            s += (f[j].x * f[j].x + f[j].y * f[j].y) + (f[j].z * f[j].z + f[j].w * f[j].w); }
        const int nt = tok + NGW;
        if (nt < M) {
#pragma unroll
            for (int j = 0; j < 4; ++j) { fw[j] = *((const v2u*)(F + (size_t)nt * DM) + lane + 64 * j); xo[j] = *((const f32x4*)(xold + (size_t)nt * DM) + lane + 64 * j); } }
        const float rstd = rsqrtf(wave_sum(s) * (1.f / DM) + RMS_EPS);
        float s2 = 0.f;
#pragma unroll
        for (int j = 0; j < 4; ++j) { const f32x4 gp = *((const f32x4*)gpost + lane + 64 * j);
            f[j] = xc[j] + f[j] * rstd * gp; *((f32x4*)(a.out + (size_t)tok * DM) + lane + 64 * j) = f[j];
            s2 += (f[j].x * f[j].x + f[j].y * f[j].y) + (f[j].z * f[j].z + f[j].w * f[j].w); }
        if (gnext) { const float r2 = rsqrtf(wave_sum(s2) * (1.f / DM) + RMS_EPS);
#pragma unroll
            for (int j = 0; j < 4; ++j) { const f32x4 gn = *((const f32x4*)gnext + lane + 64 * j); v2u w; w.x = pk2(f[j].x * r2 * gn.x, f[j].y * r2 * gn.y); w.y = pk2(f[j].z * r2 * gn.z, f[j].w * r2 * gn.w);
                *((v2u*)(XN + (size_t)tok * DM) + lane + 64 * j) = w; } }
    }
}

__global__ void __launch_bounds__(NWAVES * 64, 2) hyb_fwd(Args args) {
    extern __shared__ __attribute__((aligned(16))) unsigned char lds_raw[];
    LAS unsigned char* lds = (LAS unsigned char*)lds_raw;
    const int tid = threadIdx.x, lane = tid & 63, wave = __builtin_amdgcn_readfirstlane(tid >> 6);
    const int G = gridDim.x;
    for (int u = tid; u < (LDS_BYTES - LDSCTL_OFF) / 4; u += NWAVES * 64) ((LAS unsigned*)(lds + LDSCTL_OFF))[u] = 0u;
    __syncthreads();
    unsigned* ctl = (unsigned*)(args.ws + WS_CTL);
    XcdBarrier bar = xcd_barrier_post(ctl + CW_BAR + args.li * XCD_BAR_WORDS, (volatile LAS unsigned*)(lds + MISC_OFF) + 8);
    const int lo = args.ph_lo, hi = args.ph_hi;
#define IN(k) (lo <= (k) && (k) < hi)
#define LAUNDER int tid_ = tid; asm volatile("" : "+v"(tid_)); const int lane_ = tid_ & 63, wave_ = __builtin_amdgcn_readfirstlane(tid_ >> 6)
#define SEAM(k) do { if ((k) + 1 < hi) xcd_barrier(bar); else { VM_WAIT(); __syncthreads(); } } while (0)
    unsigned char* ws = args.ws;
    if (IN(0)) { LAUNDER; p0_prologue(args, lds, tid_, lane_, wave_); SEAM(0); }
    for (int l = 0; l < DEPTH; ++l) {
        const int pb = 1 + 9 * l;
        if (IN(pb + 0)) { for (int rep_ = 0; rep_ < 1 + ((REPMASK >> 1) & 1); ++rep_) {
            pg8::Gemm g{(const pg8::bf16_t*)(ws + WS_XN), (const pg8::bf16_t*)(ws + WS_WIN) + (size_t)l * INP * DM, M, INP, DM, (size_t)DM * 2, 128};
            pg8::StaticOrder S; S.init(M, INP, G, (int)blockIdx.x);
            pg8::EpiBf16<0> E{(pg8::bf16_t*)(ws + WS_PROJ), INP, nullptr};
            pg8::gemm_phase<pg8::EpiBf16<0>, pg8::StaticOrder, true, true>(lds + RING_OFF, g, S, E);
            SEAM(pb + 0); }
        }
        if (IN(pb + 1)) { for (int rep_ = 0; rep_ < 1 + ((REPMASK >> 2) & 1); ++rep_) { LAUNDER; p_mix_a(args, l, lds, tid_, lane_, wave_); SEAM(pb + 1); } }
        if (IN(pb + 2)) { for (int rep_ = 0; rep_ < 1 + ((REPMASK >> 3) & 1); ++rep_) { LAUNDER; p_mix_b(args, lds, tid_, lane_, wave_); SEAM(pb + 2); } }
        if (IN(pb + 3)) { for (int rep_ = 0; rep_ < 1 + ((REPMASK >> 4) & 1); ++rep_) { LAUNDER; p_groupnorm(args, l, lane_, wave_); SEAM(pb + 3); } }
        if (IN(pb + 4)) { for (int rep_ = 0; rep_ < 1 + ((REPMASK >> 5) & 1); ++rep_) {
            pg8::Gemm g{(const pg8::bf16_t*)(ws + WS_XN), (const pg8::bf16_t*)(ws + WS_WOUT) + (size_t)l * DM * DM, M, DM, DM, (size_t)DM * 2, 128};
            pg8::StaticOrder S; S.init(M, DM, G, (int)blockIdx.x);
            pg8::EpiBf16<0> E{(pg8::bf16_t*)(ws + WS_F), DM, nullptr};
            pg8::gemm_phase<pg8::EpiBf16<0>, pg8::StaticOrder, true, true>(lds + RING_OFF, g, S, E);
            SEAM(pb + 4); }
        }
        if (IN(pb + 5)) {
            for (int rep_ = 0; rep_ < 1 + (l == 0 ? 4 * ((REPMASK >> 6) & 1) : 0); ++rep_) { LAUNDER; p_postnorm(args, l == 0 ? args.in[I_X] : args.out, args.in[I_LNAPOST] + (size_t)l * DM, args.in[I_LNFP] + (size_t)l * DM, lane_, wave_); SEAM(pb + 5); }
        }
        if (IN(pb + 6)) { for (int rep_ = 0; rep_ < 1 + ((REPMASK >> 7) & 1); ++rep_) {
            pg8::Gemm g{(const pg8::bf16_t*)(ws + WS_XN), (const pg8::bf16_t*)(ws + WS_WGU) + (size_t)l * NGU * DM, M, NGU, DM, (size_t)DM * 2, 128};
            pg8::StaticOrder S; S.init(M, NGU, G, (int)blockIdx.x);
            pg8::EpiSwiGLU E{(pg8::bf16_t*)(ws + WS_HID), DFF};
            pg8::gemm_phase<pg8::EpiSwiGLU, pg8::StaticOrder, true, true>(lds + RING_OFF, g, S, E);
            SEAM(pb + 6); }
        }
        if (IN(pb + 7)) { for (int rep_ = 0; rep_ < 1 + ((REPMASK >> 8) & 1); ++rep_) {
            pg8::Gemm g{(const pg8::bf16_t*)(ws + WS_HID), (const pg8::bf16_t*)(ws + WS_WDN) + (size_t)l * DM * DFF, M, DM, DFF, (size_t)DFF * 2, 128};
            pg8::StaticOrder S; S.init(M, DM, G, (int)blockIdx.x);
            pg8::EpiBf16<0> E{(pg8::bf16_t*)(ws + WS_F), DM, nullptr};
            pg8::gemm_phase<pg8::EpiBf16<0>, pg8::StaticOrder, true, true>(lds + RING_OFF, g, S, E);
            SEAM(pb + 7); }
        }
        if (IN(pb + 8)) {
            LAUNDER; p_postnorm(args, args.out, args.in[I_LNFPOST] + (size_t)l * DM, l + 1 < DEPTH ? args.in[I_LNAP] + (size_t)(l + 1) * DM : nullptr, lane_, wave_); SEAM(pb + 8);
        }
    }
#undef IN
#undef SEAM
}

#ifndef PHMASK
#define PHMASK 0xFFF
#endif
#ifndef MK_ONE_LAUNCH
#define MK_ONE_LAUNCH 1
#endif
extern "C" void kernel_launch(void* const* d_in, const int* in_sizes, int n_in, void* d_out, int out_size, void* d_ws, size_t ws_size, hipStream_t stream) {
    static int grid = 0;
    if (grid == 0) {
        if (n_in != 17 || in_sizes[0] != M * DM || out_size != M * DM || ws_size < WS_END) { fprintf(stderr, "kernel_launch: unexpected shapes (n_in %d, in0 %d, out %d, ws %zu); nothing launched\n", n_in, n_in > 0 ? in_sizes[0] : -1, out_size, ws_size); grid = -1; return; }
        int dev = 0, cus = 0, per_cu = 0;
        if (hipGetDevice(&dev) != hipSuccess || hipDeviceGetAttribute(&cus, hipDeviceAttributeMultiprocessorCount, dev) != hipSuccess) { grid = -1; return; }
        if (hipFuncSetAttribute((const void*)hyb_fwd, hipFuncAttributeMaxDynamicSharedMemorySize, LDS_BYTES) != hipSuccess) { fprintf(stderr, "kernel_launch: hipFuncSetAttribute failed\n"); grid = -1; return; }
        if (hipOccupancyMaxActiveBlocksPerMultiprocessor(&per_cu, (const void*)hyb_fwd, NWAVES * 64, LDS_BYTES) != hipSuccess || per_cu < 1) fprintf(stderr, "kernel_launch: occupancy query reports %d workgroups per CU\n", per_cu);
        (void)hipGetLastError();
        grid = cus;
    }
    if (grid < 0) return;
    if (hipMemsetAsync((char*)d_ws + WS_CTL, 0, CTL_ZERO_BYTES, stream) != hipSuccess) return;
    Args a{};
    for (int i = 0; i < 17; ++i) a.in[i] = (const float*)d_in[i];
    a.out = (float*)d_out; a.ws = (unsigned char*)d_ws;
#if MK_ONE_LAUNCH
    a.ph_lo = 0; a.ph_hi = NPH; a.li = 0;
    hipLaunchKernelGGL(hyb_fwd, dim3(grid), dim3(NWAVES * 64), LDS_BYTES, stream, a);
#else
    for (int p = 0; p < NPH; ++p) { a.ph_lo = p; a.ph_hi = p + 1; a.li = p;
        hipLaunchKernelGGL(hyb_fwd, dim3(grid), dim3(NWAVES * 64), LDS_BYTES, stream, a); }
#endif
}
```
